# Optimizing an MI355X kernel written in HIP

```python
import jax, jax.numpy as jnp
from jax import lax
import numpy as np

D_MODEL = 1024
BATCH = 8
SEQ = 2048
DEPTH = 4

GRID_W = 64
CTX_LEN = 256
HEAD_DIM = 64
MIX_WIDTH = D_MODEL
A_HEADS = MIX_WIDTH // (2 * HEAD_DIM)
A_WIDTH = A_HEADS * HEAD_DIM
DECAY_LORA = 64
ICLR_LORA = 64
GATE_LORA = 128
B_HEADS = MIX_WIDTH // (2 * HEAD_DIM)
B_KV_HEADS = 2
WINDOW = 128
BLOCK = 128
C_HEADS = MIX_WIDTH // (2 * HEAD_DIM)
NA_KH = 8
NA_KW = 16
NA_QC = 16
NA_KC = 32
D_HEADS = MIX_WIDTH // (2 * HEAD_DIM)
D_KV_HEADS = 2
D_FF = 4 * D_MODEL
ROPE_BASE = 10000.0
NORM_EPS = 1e-6
GN_EPS = 64e-5
NEG_INF = -1e30
ATTN_SCALE = HEAD_DIM ** -0.5
N_EVEN = (DEPTH + 1) // 2
N_ODD = DEPTH // 2
A_IN = 3 * A_WIDTH + 2 * DECAY_LORA + 2 * ICLR_LORA + GATE_LORA
B_IN = (B_HEADS + 2 * B_KV_HEADS) * HEAD_DIM
C_IN = 3 * C_HEADS * HEAD_DIM
D_IN = (D_HEADS + 2 * D_KV_HEADS) * HEAD_DIM
EVEN_IN = A_IN + B_IN
ODD_IN = C_IN + D_IN
A_SPLITS = (A_WIDTH, 2 * A_WIDTH, 3 * A_WIDTH, 3 * A_WIDTH + 2 * DECAY_LORA,
            3 * A_WIDTH + 2 * DECAY_LORA + 2 * ICLR_LORA)

kernel_name = "hybrid_rwkv7_window_natten_gqa_diffusion_trunk"


def rms_norm(x, g):
    xf = x.astype(jnp.float32)
    y = xf * lax.rsqrt(jnp.mean(xf * xf, axis=-1, keepdims=True) + NORM_EPS)
    return (y * g.astype(jnp.float32)).astype(x.dtype)


def modulate(h, gain, shift, scale):
    return rms_norm(h, gain) * (1 + scale) + shift


def sqrelu_mlp(u, w1, w2):
    return jnp.square(jax.nn.relu(u @ w1)) @ w2


def axial_angles(n_tok):
    t = jnp.arange(n_tok, dtype=jnp.int32)
    n_freq = HEAD_DIM // 4
    inv_freq = ROPE_BASE ** (-jnp.arange(n_freq, dtype=jnp.float32) / n_freq)
    row = (t // GRID_W).astype(jnp.float32)[:, None] * inv_freq
    col = (t % GRID_W).astype(jnp.float32)[:, None] * inv_freq
    return row, col


def _rotate(x, ang):
    f = ang.shape[-1]
    cos = jnp.cos(ang)[None, :, None, :]
    sin = jnp.sin(ang)[None, :, None, :]
    x1 = x[..., :f].astype(jnp.float32)
    x2 = x[..., f:].astype(jnp.float32)
    return jnp.concatenate([x1 * cos - x2 * sin, x1 * sin + x2 * cos], axis=-1).astype(x.dtype)


def axial_rope(x, ang):
    half = HEAD_DIM // 2
    return jnp.concatenate([_rotate(x[..., :half], ang[0]), _rotate(x[..., half:], ang[1])], axis=-1)


def split_qkv(p, hq, hkv):
    bn, s, _ = p.shape
    q, k, v = jnp.split(p, [hq * HEAD_DIM, (hq + hkv) * HEAD_DIM], axis=-1)
    return (q.reshape(bn, s, hq, HEAD_DIM), k.reshape(bn, s, hkv, HEAD_DIM), v.reshape(bn, s, hkv, HEAD_DIM))


def softmax_with_sink(s, sink):
    sk = jnp.broadcast_to(sink.astype(jnp.float32)[:, :, None, None], s.shape[:-1] + (1,))
    return jax.nn.softmax(jnp.concatenate([s, sk], axis=-1), axis=-1)[..., :-1]


def context_attention(q, k, v, sink=None):
    bn, l, h, d = q.shape
    hkv = k.shape[2]
    qg = q.reshape(bn, l, hkv, h // hkv, d)
    s = jnp.einsum('blkgd,bckd->bkglc', qg, k).astype(jnp.float32) * ATTN_SCALE
    p = jax.nn.softmax(s, axis=-1) if sink is None else softmax_with_sink(s, sink)
    o = jnp.einsum('bkglc,bckd->blkgd', p.astype(v.dtype), v)
    return o.reshape(bn, l, h * d)


def centred_shift(p, mu_prev, mu_next):
    prev = jnp.pad(p, ((0, 0), (1, 0), (0, 0)))[:, :-1]
    nxt = jnp.pad(p, ((0, 0), (0, 1), (0, 0)))[:, 1:]
    return p + mu_prev * (prev - p) + mu_next * (nxt - p)


def rwkv7_prepare(pa, prm):
    p = centred_shift(pa, prm['mu_prev'], prm['mu_next']).astype(jnp.float32)
    bn, s, _ = p.shape
    r, k, v, wl, al, gl = jnp.split(p, A_SPLITS, axis=-1)
    wl = wl.reshape(bn, s, 2, DECAY_LORA)
    al = al.reshape(bn, s, 2, ICLR_LORA)
    w_raw = prm['w0'] + jnp.einsum('bsdl,dlc->bsdc', jnp.tanh(wl), prm['w2'])
    decay = jnp.exp(-jnp.exp(-jax.nn.softplus(-w_raw) - 0.5))
    iclr = jax.nn.sigmoid(prm['a0'] + jnp.einsum('bsdl,dlc->bsdc', al, prm['a2']))
    g = jax.nn.sigmoid(gl) @ prm['g2']
    kk = (k * prm['k_k']).reshape(bn, s, A_HEADS, HEAD_DIM)
    kk = kk / jnp.maximum(jnp.sqrt(jnp.sum(kk * kk, axis=-1, keepdims=True)), 1e-12)
    k_dir = k[:, :, None, :] * (1 + (iclr - 1) * prm['k_a'])
    heads = lambda t: t.reshape(t.shape[:-1] + (A_HEADS, HEAD_DIM))
    return dict(r=heads(r), v=heads(v), g=g, kk=kk, k=heads(k_dir), w=heads(decay), a=heads(iclr))


def rwkv7_scan(f, d, s0, reverse):
    def step(state, inp):
        r_t, w_t, k_t, v_t, kk_t, a_t = inp
        sa = jnp.einsum('bhvk,bhk->bhv', state, -kk_t)
        state = (state * w_t[:, :, None, :] + sa[..., None] * (kk_t * a_t)[:, :, None, :]
                 + v_t[..., None] * k_t[:, :, None, :])
        return state, jnp.einsum('bhvk,bhk->bhv', state, r_t)
    seq = (f['r'], f['w'][:, :, d], f['k'][:, :, d], f['v'], f['kk'], f['a'][:, :, d])
    xs = tuple(jnp.moveaxis(t, 1, 0) for t in seq)
    s_last, ys = lax.scan(step, s0, xs, reverse=reverse)
    return s_last, jnp.moveaxis(ys, 0, 1)


def rwkv7_output(f, y, prm, dtype):
    bn, s = y.shape[:2]
    mu = jnp.mean(y, axis=-1, keepdims=True)
    var = jnp.mean(jnp.square(y - mu), axis=-1, keepdims=True)
    yn = ((y - mu) * lax.rsqrt(var + GN_EPS)).reshape(bn, s, A_WIDTH) * prm['gn_w'] + prm['gn_b']
    bonus = jnp.sum(f['r'][:, :, None] * f['k'] * prm['r_k'], axis=(2, 4))
    yn = yn + (bonus[..., None] * f['v']).reshape(bn, s, A_WIDTH)
    return (yn * f['g']).astype(dtype)


def rwkv7_mixer(pa_ctx, pa_lat, prm, need_ctx):
    fc = rwkv7_prepare(pa_ctx, prm)
    fl = rwkv7_prepare(pa_lat, prm)
    zero = jnp.zeros((pa_lat.shape[0], A_HEADS, HEAD_DIM, HEAD_DIM), jnp.float32)
    s_cf, yc_f = rwkv7_scan(fc, 0, zero, False)
    _, yl_f = rwkv7_scan(fl, 0, s_cf, False)
    s_cb, yc_b = rwkv7_scan(fc, 1, zero, True)
    _, yl_b = rwkv7_scan(fl, 1, s_cb, True)
    out_lat = rwkv7_output(fl, yl_f + yl_b, prm, pa_lat.dtype)
    out_ctx = rwkv7_output(fc, yc_f + yc_b, prm, pa_ctx.dtype) if need_ctx else None
    return out_lat, out_ctx


def banded_window_attention(q, k, v, k_ctx, v_ctx, sink):
    bn, s, h, d = q.shape
    hkv = k.shape[2]
    nb = s // BLOCK
    qb = q.reshape(bn, nb, BLOCK, hkv, h // hkv, d)

    def band(t):
        tp = jnp.pad(t, ((0, 0), (BLOCK, BLOCK), (0, 0), (0, 0)))
        return jnp.concatenate([tp[:, j * BLOCK: j * BLOCK + s].reshape(bn, nb, BLOCK, hkv, d)
                                for j in range(3)], axis=2)
    kb, vb = band(k), band(v)
    qi = np.arange(BLOCK)[:, None]
    kj = np.arange(3 * BLOCK)[None, :]
    kpos = (np.arange(nb) * BLOCK)[:, None, None] - BLOCK + kj[None]
    ok = (np.abs(kj - BLOCK - qi) <= WINDOW)[None] & (kpos >= 0) & (kpos < s)
    s_lat = jnp.einsum('bnqkgd,bnjkd->bnkgqj', qb, kb).astype(jnp.float32) * ATTN_SCALE
    s_lat = jnp.where(ok[None, :, None, None], s_lat, NEG_INF)
    s_ctx = jnp.einsum('bnqkgd,bckd->bnkgqc', qb, k_ctx).astype(jnp.float32) * ATTN_SCALE
    p = softmax_with_sink(jnp.concatenate([s_lat, s_ctx], axis=-1), sink)
    p_lat, p_ctx = p[..., :3 * BLOCK].astype(v.dtype), p[..., 3 * BLOCK:].astype(v.dtype)
    o = (jnp.einsum('bnkgqj,bnjkd->bnqkgd', p_lat, vb)
         + jnp.einsum('bnkgqc,bckd->bnqkgd', p_ctx, v_ctx))
    return o.reshape(bn, s, h * d)


def neighbourhood_tables(rows):
    kh = min(NA_KH, rows)
    r = np.arange(rows)
    row_idx = np.clip(r - kh // 2, 0, rows - kh)[:, None] + np.arange(kh)[None, :]
    dr = row_idx - r[:, None] + NA_KH - 1
    ncb = GRID_W // NA_QC
    q_col = np.arange(ncb)[:, None] * NA_QC + np.arange(NA_QC)[None, :]
    key_col = (np.clip(np.arange(ncb) * NA_QC - NA_KW // 2, 0, GRID_W - NA_KC)[:, None]
               + np.arange(NA_KC)[None, :])
    win_start = np.clip(q_col - NA_KW // 2, 0, GRID_W - NA_KW)[:, :, None]
    kc = key_col[:, None, :]
    col_ok = (kc >= win_start) & (kc < win_start + NA_KW)
    dc = np.clip(kc - q_col[:, :, None] + NA_KW - 1, 0, 2 * NA_KW - 2)
    return row_idx, dr, key_col, col_ok, dc


def neighbourhood_attention(q, k, v, k_ctx, v_ctx, rpb):
    bn, s, h, d = q.shape
    rows = s // GRID_W
    ncb = GRID_W // NA_QC
    row_idx, dr, key_col, col_ok, dc = neighbourhood_tables(rows)
    kh = row_idx.shape[1]

    def gather(t):
        return t.reshape(bn, rows, GRID_W, h, d)[:, row_idx][:, :, :, key_col]
    kg, vg = gather(k), gather(v)
    qg = q.reshape(bn, rows, ncb, NA_QC, h, d)
    s_lat = jnp.einsum('brmqhd,brtmjhd->brmhqtj', qg, kg).astype(jnp.float32) * ATTN_SCALE
    bias = rpb[:, dr[:, None, None, :, None], dc[None, :, :, None, :]]
    s_lat = s_lat + bias.transpose(1, 2, 0, 3, 4, 5).astype(jnp.float32)
    s_lat = jnp.where(col_ok[:, None, :, None, :], s_lat, NEG_INF)
    s_lat = s_lat.reshape(s_lat.shape[:-2] + (kh * NA_KC,))
    s_ctx = jnp.einsum('brmqhd,bchd->brmhqc', qg, k_ctx).astype(jnp.float32) * ATTN_SCALE
    p = jax.nn.softmax(jnp.concatenate([s_lat, s_ctx], axis=-1), axis=-1)
    p_lat = p[..., :kh * NA_KC].reshape(p.shape[:-1] + (kh, NA_KC)).astype(v.dtype)
    p_ctx = p[..., kh * NA_KC:].astype(v.dtype)
    o = (jnp.einsum('brmhqtj,brtmjhd->brmqhd', p_lat, vg)
         + jnp.einsum('brmhqc,bchd->brmqhd', p_ctx, v_ctx))
    return o.reshape(bn, s, h * d)


def global_block_attention(q, k, v, k_ctx, v_ctx):
    bn, s, h, d = q.shape
    hkv = k.shape[2]
    nb = s // BLOCK
    k_all = jnp.concatenate([k_ctx, k], axis=1)
    v_all = jnp.concatenate([v_ctx, v], axis=1)
    qb = q.reshape(bn, nb, BLOCK, hkv, h // hkv, d).transpose(1, 0, 2, 3, 4, 5)

    def one_block(qblk):
        sc = jnp.einsum('bqkgd,bskd->bkgqs', qblk, k_all).astype(jnp.float32) * ATTN_SCALE
        p = jax.nn.softmax(sc, axis=-1).astype(v_all.dtype)
        return jnp.einsum('bkgqs,bskd->bqkgd', p, v_all)
    o = lax.map(one_block, qb)
    return o.transpose(1, 0, 2, 3, 4, 5).reshape(bn, s, h * d)


def even_mixer(u_ctx, u_lat, w_in, w_out, a_prm, sink, rope_ang, need_ctx):
    p_ctx = u_ctx @ w_in
    p_lat = u_lat @ w_in
    a_lat, a_ctx = rwkv7_mixer(p_ctx[..., :A_IN], p_lat[..., :A_IN], a_prm, need_ctx)
    qc, kc, vc = split_qkv(p_ctx[..., A_IN:], B_HEADS, B_KV_HEADS)
    ql, kl, vl = split_qkv(p_lat[..., A_IN:], B_HEADS, B_KV_HEADS)
    ql, kl = axial_rope(ql, rope_ang), axial_rope(kl, rope_ang)
    sink_g = sink.reshape(B_KV_HEADS, B_HEADS // B_KV_HEADS)
    b_lat = banded_window_attention(ql, kl, vl, kc, vc, sink_g)
    out_lat = jnp.concatenate([a_lat, b_lat], axis=-1) @ w_out
    if not need_ctx:
        return out_lat, None
    b_ctx = context_attention(qc, kc, vc, sink_g)
    return out_lat, jnp.concatenate([a_ctx, b_ctx], axis=-1) @ w_out


def odd_mixer(u_ctx, u_lat, w_in, w_out, rpb, q_gain, k_gain, rope_ang, need_ctx):
    p_ctx = u_ctx @ w_in
    p_lat = u_lat @ w_in
    cq_c, ck_c, cv_c = split_qkv(p_ctx[..., :C_IN], C_HEADS, C_HEADS)
    cq_l, ck_l, cv_l = split_qkv(p_lat[..., :C_IN], C_HEADS, C_HEADS)
    c_lat = neighbourhood_attention(cq_l, ck_l, cv_l, ck_c, cv_c, rpb)
    dq_c, dk_c, dv_c = split_qkv(p_ctx[..., C_IN:], D_HEADS, D_KV_HEADS)
    dq_l, dk_l, dv_l = split_qkv(p_lat[..., C_IN:], D_HEADS, D_KV_HEADS)
    dq_c, dk_c = rms_norm(dq_c, q_gain), rms_norm(dk_c, k_gain)
    dq_l = axial_rope(rms_norm(dq_l, q_gain), rope_ang)
    dk_l = axial_rope(rms_norm(dk_l, k_gain), rope_ang)
    d_lat = global_block_attention(dq_l, dk_l, dv_l, dk_c, dv_c)
    out_lat = jnp.concatenate([c_lat, d_lat], axis=-1) @ w_out
    if not need_ctx:
        return out_lat, None
    c_ctx_o = context_attention(cq_c, ck_c, cv_c)
    d_ctx_o = context_attention(dq_c, dk_c, dv_c)
    return out_lat, jnp.concatenate([c_ctx_o, d_ctx_o], axis=-1) @ w_out


def setup_inputs(seed: int = 0) -> dict:
    key = jax.random.key(seed)
    ks = iter(jax.random.split(key, 40))
    nrm = lambda shape, scale: scale * jax.random.normal(next(ks), shape, jnp.float32)
    unif = lambda shape, lo, hi: jax.random.uniform(next(ks), shape, jnp.float32, lo, hi)
    D = D_MODEL
    return {
        "x": nrm((BATCH, SEQ, D), 1.0),
        "c": nrm((BATCH, D), 1.0),
        "ctx": nrm((BATCH, CTX_LEN, D), 1.0),
        "c_ctx": nrm((D,), 1.0),
        "w_ada": nrm((DEPTH, D, 6 * D), 0.5 * D ** -0.5),
        "b_ada": nrm((DEPTH, 6 * D), 0.02),
        "g_pre_mix": 1.0 + nrm((DEPTH, D), 0.05),
        "g_post_mix": 1.0 + nrm((DEPTH, D), 0.05),
        "g_pre_ff": 1.0 + nrm((DEPTH, D), 0.05),
        "g_post_ff": 1.0 + nrm((DEPTH, D), 0.05),
        "w_in_even": nrm((N_EVEN, D, EVEN_IN), D ** -0.5),
        "w_in_odd": nrm((N_ODD, D, ODD_IN), D ** -0.5),
        "w_out": nrm((DEPTH, MIX_WIDTH, D), MIX_WIDTH ** -0.5),
        "w_ff1": nrm((DEPTH, D, D_FF), D ** -0.5),
        "w_ff2": nrm((DEPTH, D_FF, D), D_FF ** -0.5),
        "a_mu_prev": unif((N_EVEN, A_IN), 0.05, 0.45),
        "a_mu_next": unif((N_EVEN, A_IN), 0.05, 0.45),
        "a_w0": unif((N_EVEN, 2, A_WIDTH), -5.0, -0.5),
        "a_w2": nrm((N_EVEN, 2, DECAY_LORA, A_WIDTH), 0.1 * DECAY_LORA ** -0.5),
        "a_a0": nrm((N_EVEN, 2, A_WIDTH), 0.1),
        "a_a2": nrm((N_EVEN, 2, ICLR_LORA, A_WIDTH), 0.5 * ICLR_LORA ** -0.5),
        "a_g2": nrm((N_EVEN, GATE_LORA, A_WIDTH), GATE_LORA ** -0.5),
        "a_k_k": 0.85 + nrm((N_EVEN, A_WIDTH), 0.05),
        "a_k_a": 1.0 + nrm((N_EVEN, A_WIDTH), 0.05),
        "a_r_k": nrm((N_EVEN, A_HEADS, HEAD_DIM), 0.1),
        "a_gn_w": 1.0 + nrm((N_EVEN, A_WIDTH), 0.05),
        "a_gn_b": nrm((N_EVEN, A_WIDTH), 0.02),
        "b_sink": nrm((N_EVEN, B_HEADS), 0.5),
        "c_rpb": nrm((N_ODD, C_HEADS, 2 * NA_KH - 1, 2 * NA_KW - 1), 0.5),
        "d_q_gain": 1.0 + nrm((N_ODD, HEAD_DIM), 0.05),
        "d_k_gain": 1.0 + nrm((N_ODD, HEAD_DIM), 0.05),
    }


def reference(x, c, ctx, c_ctx, w_ada, b_ada, g_pre_mix, g_post_mix, g_pre_ff, g_post_ff,
              w_in_even, w_in_odd, w_out, w_ff1, w_ff2,
              a_mu_prev, a_mu_next, a_w0, a_w2, a_a0, a_a2, a_g2, a_k_k, a_k_a, a_r_k, a_gn_w, a_gn_b,
              b_sink, c_rpb, d_q_gain, d_k_gain):
    rope_ang = axial_angles(x.shape[1])
    s_lat = jax.nn.silu(c)[:, None, :]
    s_ctx = jax.nn.silu(c_ctx)[None, None, :]
    h_lat, h_ctx = x, ctx
    for i in range(DEPTH):
        need_ctx = i < DEPTH - 1
        j = i // 2
        ml = jnp.split(s_lat @ w_ada[i] + b_ada[i], 6, axis=-1)
        mc = jnp.split(s_ctx @ w_ada[i] + b_ada[i], 6, axis=-1)
        u_lat = modulate(h_lat, g_pre_mix[i], ml[0], ml[1])
        u_ctx = modulate(h_ctx, g_pre_mix[i], mc[0], mc[1])
        if i % 2 == 0:
            a_prm = dict(mu_prev=a_mu_prev[j], mu_next=a_mu_next[j], w0=a_w0[j], w2=a_w2[j],
                         a0=a_a0[j], a2=a_a2[j], g2=a_g2[j], k_k=a_k_k[j], k_a=a_k_a[j],
                         r_k=a_r_k[j], gn_w=a_gn_w[j], gn_b=a_gn_b[j])
            o_lat, o_ctx = even_mixer(u_ctx, u_lat, w_in_even[j], w_out[i], a_prm, b_sink[j], rope_ang, need_ctx)
        else:
            o_lat, o_ctx = odd_mixer(u_ctx, u_lat, w_in_odd[j], w_out[i], c_rpb[j], d_q_gain[j], d_k_gain[j],
                                     rope_ang, need_ctx)
        h_lat = h_lat + ml[2] * rms_norm(o_lat, g_post_mix[i])
        f_lat = sqrelu_mlp(modulate(h_lat, g_pre_ff[i], ml[3], ml[4]), w_ff1[i], w_ff2[i])
        h_lat = h_lat + ml[5] * rms_norm(f_lat, g_post_ff[i])
        if need_ctx:
            h_ctx = h_ctx + mc[2] * rms_norm(o_ctx, g_post_mix[i])
            f_ctx = sqrelu_mlp(modulate(h_ctx, g_pre_ff[i], mc[3], mc[4]), w_ff1[i], w_ff2[i])
            h_ctx = h_ctx + mc[5] * rms_norm(f_ctx, g_post_ff[i])
    return h_lat
```

```cpp
#include <hip/hip_runtime.h>
#include <hip/hip_cooperative_groups.h>
#include <cstdio>
#include <cstdint>
namespace cg = cooperative_groups;

namespace pg8 {
#define PG8_LAS __attribute__((address_space(3)))
typedef unsigned short bf16_t;
typedef short bf16x8 __attribute__((ext_vector_type(8)));
typedef float f32x4 __attribute__((ext_vector_type(4)));
typedef unsigned u32x4 __attribute__((ext_vector_type(4)));
constexpr int BM = 256, BK = 64, HALF = 128, HTB = HALF * BK * 2  , STAGE_BYTES = 8 * HTB, NXCD = 8, WGM = 8;

__host__ __device__ __forceinline__ int lds_byte(int r, int c) { const int st = (r >> 4) * 2 + (c >> 5), rr = r & 15, cc = c & 31, ob = rr * 64 + cc * 2; return st * 1024 + (ob ^ (((ob >> 9) & 1) << 5)); }
__host__ __device__ __forceinline__ void stage_rc(int b, int& R, int& C) { const int st = b / 1024, sb = b % 1024, swz = sb ^ (((sb >> 9) & 1) << 5); R = (st >> 1) * 16 + swz / 64; C = (st & 1) * 32 + (swz % 64) / 2; }
__host__ __device__ __forceinline__ int perm32(int rho) { const int n = rho >> 4, i = rho & 15; return 8 * (i >> 2) + 4 * n + (i & 3); }

struct Unit { int pm, pn; };
struct Gemm { const bf16_t* A; const bf16_t* Bt; int M, N, K, lda; };

struct StaticOrder {
    int nM, nN, nwg, G, c;
    __host__ __device__ void init(int M, int N, int G_, int c_) { nM = M / BM; nN = N / BM; nwg = nM * nN; G = G_; c = c_; }
    __host__ __device__ bool next(int i, Unit& u) const {
        const long L = (long)i * G + c; if (L >= nwg) return false;
        int wgid = (int)L; { const int q = nwg / NXCD, r = nwg % NXCD, xcd = wgid % NXCD, off = wgid / NXCD; wgid = (xcd < r ? xcd * (q + 1) : r * (q + 1) + (xcd - r) * q) + off; }
        const int nig = WGM * nN, gid = wgid / nig, fm = gid * WGM, gsz = (nM - fm) < WGM ? (nM - fm) : WGM;
        u.pm = fm + ((wgid % nig) % gsz); u.pn = (wgid % nig) / gsz; return true;
    }
    __device__ __forceinline__ void a_ready(const Unit&) const {}
    __device__ __forceinline__ void done(const Unit&) const {}
};

__device__ __forceinline__ unsigned cvt_pk_bf16(float lo, float hi) { unsigned r; asm volatile("v_cvt_pk_bf16_f32 %0, %1, %2" : "=v"(r) : "v"(lo), "v"(hi)); return r; }

struct EpiBf16 {
    static constexpr bool PERM = true, AFTER_DRAIN = false;
    bf16_t* O; int ldc; bool sq;
    __device__ __forceinline__ void operator()(const f32x4 (&acc)[2][2][4][2], const Unit& u, int wr, int wc, int fr, int fq) const {
        const int row0 = u.pm * BM + wr * 64 + fr; const int col0 = u.pn * BM + wc * 32 + 8 * fq;
#pragma unroll
        for (int ai = 0; ai < 2; ++ai)
#pragma unroll
            for (int m = 0; m < 4; ++m) { bf16_t* rowp = O + (size_t)(row0 + ai * HALF + m * 16) * ldc + col0;
#pragma unroll
                for (int bj = 0; bj < 2; ++bj) { f32x4 v0 = acc[ai][bj][m][0], v1 = acc[ai][bj][m][1];
                    if (sq) {
#pragma unroll
                        for (int e = 0; e < 4; ++e) { float a = fmaxf(v0[e], 0.f), b = fmaxf(v1[e], 0.f); v0[e] = a * a; v1[e] = b * b; } }
                    u32x4 w; w.x = cvt_pk_bf16(v0[0], v0[1]); w.y = cvt_pk_bf16(v0[2], v0[3]); w.z = cvt_pk_bf16(v1[0], v1[1]); w.w = cvt_pk_bf16(v1[2], v1[3]);
                    *(u32x4*)(rowp + bj * HALF) = w; } }
    }
};

struct EpiF32 {
    static constexpr bool PERM = false, AFTER_DRAIN = false;
    float* C; int ldc;
    __device__ __forceinline__ void operator()(const f32x4 (&acc)[2][2][4][2], const Unit& u, int wr, int wc, int fr, int fq) const {
        const int row0 = u.pm * BM + wr * 64 + fr, col0 = u.pn * BM + wc * 32 + 4 * fq;
#pragma unroll
        for (int ai = 0; ai < 2; ++ai)
#pragma unroll
            for (int m = 0; m < 4; ++m) { float* rowp = C + (size_t)(row0 + ai * HALF + m * 16) * ldc + col0;
#pragma unroll
                for (int bj = 0; bj < 2; ++bj)
#pragma unroll
                    for (int n = 0; n < 2; ++n) *(f32x4*)(rowp + bj * HALF + n * 16) = acc[ai][bj][m][n]; }
    }
};


template <class Epi, class Sched, bool ALIGN_EPI = false, bool SP2 = false>
__device__ __forceinline__ void gemm_phase(PG8_LAS unsigned char* lds, const Gemm g, const Sched& S, const Epi& E, const int tid_in) {
    int tid_ = tid_in; asm volatile("" : "+v"(tid_));
    const int tid = tid_, wid = __builtin_amdgcn_readfirstlane(tid >> 6), lane = tid & 63, wr = wid >> 2, wc = wid & 3, fr = lane & 15, fq = lane >> 4;
    const int K = g.K, nt = K / BK;
    unsigned voffA[2], voffB[2];
#pragma unroll
    for (int i = 0; i < 2; ++i) { int R, C; stage_rc(tid * 16 + i * 8192, R, C); const int Rb = Epi::PERM ? ((R & ~31) + perm32(R & 31)) : R;
        voffA[i] = (unsigned)(R * g.lda + C) * 2u; voffB[i] = (unsigned)(Rb * K + C) * 2u; }
    const size_t kstep = (size_t)(BK * 2);
    const size_t hstepA = (size_t)HALF * g.lda * 2, hstepB = (size_t)HALF * K * 2;
    const size_t tstepA = 2 * hstepA, tstepB = 2 * hstepB;
    const unsigned ldsw = (unsigned)wid * 1024u;
    const int aoff = lds_byte(wr * 64 + fr, fq * 8), boff = lds_byte(wc * 32 + fr, fq * 8);
#define PG8_SA(b, h) (((b) * 2 + (h)) * HTB)
#define PG8_SB(b, h) ((4 + (b) * 2 + (h)) * HTB)
#define PG8_STAGE(bufoff, gbase, voff) do { _Pragma("unroll") for (int _i = 0; _i < 2; ++_i) \
        __builtin_amdgcn_global_load_lds((const unsigned*)((const char*)(gbase) + (voff)[_i]), (PG8_LAS unsigned*)(lds + (bufoff) + ldsw + _i * 8192), 16, 0, 0); } while (0)
#define PG8_LDA(dst, b, h) do { _Pragma("unroll") for (int m = 0; m < 4; ++m) _Pragma("unroll") for (int k = 0; k < 2; ++k) dst[m][k] = *(const PG8_LAS bf16x8*)(lds + PG8_SA(b, h) + aoff + m * 2048 + k * 1024); } while (0)
#define PG8_LDB(dst, b, h) do { _Pragma("unroll") for (int n = 0; n < 2; ++n) _Pragma("unroll") for (int k = 0; k < 2; ++k) dst[n][k] = *(const PG8_LAS bf16x8*)(lds + PG8_SB(b, h) + boff + n * 2048 + k * 1024); } while (0)
#define PG8_MMA(ai, bj, At, Bt) do { __builtin_amdgcn_s_setprio(1); _Pragma("unroll") for (int m = 0; m < 4; ++m) _Pragma("unroll") for (int n = 0; n < 2; ++n) _Pragma("unroll") for (int k = 0; k < 2; ++k) \
        acc[ai][bj][m][n] = __builtin_amdgcn_mfma_f32_16x16x32_bf16(Bt[n][k], At[m][k], acc[ai][bj][m][n], 0, 0, 0); __builtin_amdgcn_s_setprio(0); } while (0)
#define PG8_WAIT_V(n) asm volatile("s_waitcnt vmcnt(" #n ")" ::: "memory")
#define PG8_WAIT_L(n) asm volatile("s_waitcnt lgkmcnt(" #n ")" ::: "memory")
#define PG8_BAR __builtin_amdgcn_s_barrier()
#define PG8_SCHED __builtin_amdgcn_sched_barrier(0)
    Unit cur, nxt; int ui = 0;
    if (!S.next(0, cur)) return;
    f32x4 acc[2][2][4][2];
#pragma unroll
    for (int a = 0; a < 2; ++a)
#pragma unroll
        for (int b = 0; b < 2; ++b)
#pragma unroll
            for (int m = 0; m < 4; ++m)
#pragma unroll
                for (int n = 0; n < 2; ++n) acc[a][b][m][n] = (f32x4){0.f, 0.f, 0.f, 0.f};
    bf16x8 At[4][2], B0[2][2], B1[2][2];
    const char* cA = (const char*)g.A + (size_t)cur.pm * tstepA; const char* cB = (const char*)g.Bt + (size_t)cur.pn * tstepB;
    S.a_ready(cur);
    if constexpr (SP2) {
        PG8_STAGE(PG8_SB(0, 0), cB, voffB); PG8_STAGE(PG8_SB(0, 1), cB + hstepB, voffB); PG8_STAGE(PG8_SA(0, 0), cA, voffA); PG8_STAGE(PG8_SA(0, 1), cA + hstepA, voffA);
        if (wr == 1) PG8_BAR;
        PG8_WAIT_V(2); PG8_BAR;
        PG8_STAGE(PG8_SB(1, 0), cB + kstep, voffB); PG8_STAGE(PG8_SA(1, 0), cA + kstep, voffA); PG8_STAGE(PG8_SB(1, 1), cB + hstepB + kstep, voffB);
        PG8_WAIT_V(6); PG8_BAR;
    } else {
        PG8_STAGE(PG8_SB(0, 0), cB, voffB); PG8_STAGE(PG8_SA(0, 0), cA, voffA); PG8_STAGE(PG8_SB(0, 1), cB + hstepB, voffB); PG8_STAGE(PG8_SA(0, 1), cA + hstepA, voffA);
        if (wr == 1) PG8_BAR;
        PG8_WAIT_V(4); PG8_BAR;
        PG8_STAGE(PG8_SB(1, 0), cB + kstep, voffB); PG8_STAGE(PG8_SA(1, 0), cA + kstep, voffA); PG8_STAGE(PG8_SB(1, 1), cB + hstepB + kstep, voffB);
        PG8_WAIT_V(6); PG8_BAR;
    }
    for (;;) {
        const bool has_next = S.next(ui + 1, nxt);
        const char* nA = has_next ? (const char*)g.A + (size_t)nxt.pm * tstepA : cA; const char* nB = has_next ? (const char*)g.Bt + (size_t)nxt.pn * tstepB : cB;
        for (int t = 0; t < nt; t += 2) {
            const bool last = (t == nt - 2);
            const char* a1 = cA + (size_t)(t + 1) * kstep;
            const char* a2 = last ? nA : cA + (size_t)(t + 2) * kstep; const char* b2 = last ? nB : cB + (size_t)(t + 2) * kstep;
            const char* a3 = a2 + kstep; const char* b3 = b2 + kstep;
            if (last && has_next) S.a_ready(nxt);
            if constexpr (SP2) {
            PG8_LDB(B0, 0, 0); PG8_LDB(B1, 0, 1); PG8_SCHED; PG8_LDA(At, 0, 0); PG8_STAGE(PG8_SA(1, 1), a1 + hstepA, voffA);
            PG8_WAIT_V(8); PG8_WAIT_L(0); PG8_BAR; PG8_MMA(0, 0, At, B0); PG8_MMA(0, 1, At, B1); PG8_BAR; PG8_SCHED;
            PG8_LDA(At, 0, 1); PG8_STAGE(PG8_SB(0, 0), b2, voffB); PG8_STAGE(PG8_SB(0, 1), b2 + hstepB, voffB); PG8_STAGE(PG8_SA(0, 0), a2, voffA);
            PG8_WAIT_V(8); PG8_WAIT_L(0); PG8_BAR; PG8_MMA(1, 0, At, B0); PG8_MMA(1, 1, At, B1); PG8_BAR; PG8_SCHED;
            PG8_LDB(B0, 1, 0); PG8_LDB(B1, 1, 1); PG8_SCHED; PG8_LDA(At, 1, 0); PG8_STAGE(PG8_SA(0, 1), a2 + hstepA, voffA);
            PG8_WAIT_V(8); PG8_WAIT_L(0); PG8_BAR; PG8_MMA(0, 0, At, B0); PG8_MMA(0, 1, At, B1); PG8_BAR; PG8_SCHED;
            PG8_LDA(At, 1, 1); PG8_STAGE(PG8_SB(1, 0), b3, voffB); PG8_STAGE(PG8_SB(1, 1), b3 + hstepB, voffB); PG8_STAGE(PG8_SA(1, 0), a3, voffA);
            PG8_WAIT_V(8); PG8_WAIT_L(0); PG8_BAR; PG8_MMA(1, 0, At, B0); PG8_MMA(1, 1, At, B1); PG8_BAR; PG8_SCHED;
            } else {
            PG8_LDB(B0, 0, 0); PG8_SCHED; PG8_LDA(At, 0, 0); PG8_STAGE(PG8_SA(1, 1), a1 + hstepA, voffA);
            PG8_WAIT_L(8); PG8_BAR; PG8_WAIT_L(0); PG8_MMA(0, 0, At, B0); PG8_BAR; PG8_SCHED;
            PG8_LDB(B1, 0, 1); PG8_STAGE(PG8_SB(0, 0), b2, voffB);
            PG8_BAR; PG8_WAIT_L(0); PG8_MMA(0, 1, At, B1); PG8_BAR;
            PG8_LDA(At, 0, 1); PG8_STAGE(PG8_SA(0, 0), a2, voffA);
            PG8_BAR; PG8_WAIT_L(0); PG8_MMA(1, 0, At, B0); PG8_BAR; PG8_SCHED;
            PG8_STAGE(PG8_SB(0, 1), b2 + hstepB, voffB);
            PG8_WAIT_V(6); PG8_BAR; PG8_MMA(1, 1, At, B1); PG8_BAR;
            PG8_LDB(B0, 1, 0); PG8_SCHED; PG8_LDA(At, 1, 0); PG8_STAGE(PG8_SA(0, 1), a2 + hstepA, voffA);
            PG8_WAIT_L(8); PG8_BAR; PG8_WAIT_L(0); PG8_MMA(0, 0, At, B0); PG8_BAR; PG8_SCHED;
            PG8_LDB(B1, 1, 1); PG8_STAGE(PG8_SB(1, 0), b3, voffB);
            PG8_BAR; PG8_WAIT_L(0); PG8_MMA(0, 1, At, B1); PG8_BAR;
            PG8_LDA(At, 1, 1); PG8_STAGE(PG8_SA(1, 0), a3, voffA);
            PG8_BAR; PG8_WAIT_L(0); PG8_MMA(1, 0, At, B0); PG8_BAR; PG8_SCHED;
            PG8_STAGE(PG8_SB(1, 1), b3 + hstepB, voffB);
            PG8_WAIT_V(6); PG8_BAR; PG8_MMA(1, 1, At, B1); PG8_BAR;
            }
        }
        if constexpr (ALIGN_EPI) { if (wr == 0) PG8_BAR; }
        if constexpr (!Epi::AFTER_DRAIN) { E(acc, cur, wr, wc, fr, fq); S.done(cur); }
        if (!has_next) break;
#pragma unroll
        for (int a = 0; a < 2; ++a)
#pragma unroll
            for (int b = 0; b < 2; ++b)
#pragma unroll
                for (int m = 0; m < 4; ++m)
#pragma unroll
                    for (int n = 0; n < 2; ++n) acc[a][b][m][n] = (f32x4){0.f, 0.f, 0.f, 0.f};
        cur = nxt; cA = nA; cB = nB; ++ui;
        if constexpr (ALIGN_EPI) { if (wr == 1) PG8_BAR; }
    }
    PG8_WAIT_V(0);
    if constexpr (!ALIGN_EPI) { if (wr == 0) PG8_BAR; }
    PG8_BAR;
    if constexpr (Epi::AFTER_DRAIN) { E.fused(acc, cur, wr, wc, fr, fq, lds, wid, lane); S.done(cur); }
#undef PG8_SA
#undef PG8_SB
#undef PG8_STAGE
#undef PG8_LDA
#undef PG8_LDB
#undef PG8_MMA
#undef PG8_WAIT_V
#undef PG8_WAIT_L
#undef PG8_BAR
#undef PG8_SCHED
}
}

#define LAS __attribute__((address_space(3)))
typedef unsigned short bf16_t;
typedef float f32x4 __attribute__((ext_vector_type(4)));
constexpr int D = 1024, NB = 8, SEQ = 2048, CTXL = 256, FF = 4096, HD = 64;
constexpr int ML = NB * SEQ, MC = NB * CTXL, MT = ML + MC;
constexpr int NPE = 2816, NPO = 2304, AIN = 1920;
constexpr int NWAVES = 8, NTHR = 512;
constexpr int LDS_BYTES = 147456;
constexpr float NORM_EPS = 1e-6f, GN_EPS = 64e-5f, LOG2E = 1.4426950408889634f;
constexpr size_t MiB = 1u << 20;
constexpr size_t WS_MOD = 1 * MiB, WS_ROPE = 2 * MiB, WS_W = 3 * MiB, WS_HCTX = 29 * MiB, WS_UMIX = 37 * MiB, WS_A = 73 * MiB, WS_B = 172 * MiB,
                 WS_QKVB = 316 * MiB, WS_END = 343 * MiB;
constexpr size_t W_IN = 0, W_OUT = 6 * MiB, W_1 = 8 * MiB, W_2 = 16 * MiB, W_L = 24 * MiB;
constexpr size_t TOK512 = (size_t)MT * 512;
constexpr size_t B_Y0 = 72 * MiB, B_Y1 = 108 * MiB; constexpr int NLR = 2560;
constexpr size_t WS_O2 = 217 * MiB;
constexpr int NPH = 38;

enum { I_X = 0, I_C, I_CTX, I_CCTX, I_WADA, I_BADA, I_GPREMIX, I_GPOSTMIX, I_GPREFF, I_GPOSTFF, I_WINE, I_WINO, I_WOUT, I_WFF1, I_WFF2,
       I_MUP, I_MUN, I_W0, I_W2, I_A0, I_A2, I_G2, I_KK, I_KA, I_RK, I_GNW, I_GNB, I_SINK, I_RPB, I_QG, I_KG, N_IN };

struct Args { const float* in[N_IN]; float* out; unsigned char* ws; int ph_lo, ph_hi; };
struct AV { const Args& k; int z; int wv;
    __device__ __forceinline__ const float* in(int i) const { return k.in[i + z]; }
    __device__ __forceinline__ unsigned char* ws() const { return k.ws + z; }
    __device__ __forceinline__ float* out() const { return k.out + z; } };

__device__ __forceinline__ unsigned f2bf(float f) { unsigned u = __float_as_uint(f); return (u + 0x7fffu + ((u >> 16) & 1u)) >> 16; }
__device__ __forceinline__ unsigned pk2(float lo, float hi) { return f2bf(lo) | (f2bf(hi) << 16); }
__device__ __forceinline__ float bflo(unsigned u) { return __uint_as_float(u << 16); }
__device__ __forceinline__ float bfhi(unsigned u) { return __uint_as_float(u & 0xffff0000u); }
__device__ __forceinline__ float bf1(bf16_t h) { return __uint_as_float(((unsigned)h) << 16); }
__device__ __forceinline__ void unpack8(const uint4 u, float (&f)[8]) { f[0] = bflo(u.x); f[1] = bfhi(u.x); f[2] = bflo(u.y); f[3] = bfhi(u.y); f[4] = bflo(u.z); f[5] = bfhi(u.z); f[6] = bflo(u.w); f[7] = bfhi(u.w); }
__device__ __forceinline__ uint4 pack8(const float (&f)[8]) { uint4 u; u.x = pk2(f[0], f[1]); u.y = pk2(f[2], f[3]); u.z = pk2(f[4], f[5]); u.w = pk2(f[6], f[7]); return u; }
__device__ __forceinline__ void ld8f(const float* p, float (&f)[8]) { const float4 a = *(const float4*)p, b = *(const float4*)(p + 4); f[0] = a.x; f[1] = a.y; f[2] = a.z; f[3] = a.w; f[4] = b.x; f[5] = b.y; f[6] = b.z; f[7] = b.w; }
__device__ __forceinline__ int otid(const AV& a) { int l; asm volatile("v_mbcnt_lo_u32_b32 %0, -1, 0\n\tv_mbcnt_hi_u32_b32 %0, -1, %0" : "=v"(l)); return a.wv * 64 + l; }
__device__ __forceinline__ int obid() { int b = blockIdx.x; asm volatile("" : "+s"(b)); return b; }
__device__ __forceinline__ float wave_sum(float v) {
#pragma unroll
    for (int o = 1; o < 64; o <<= 1) v += __shfl_xor(v, o);
    return v;
}
__device__ __forceinline__ float wave_max(float v) {
#pragma unroll
    for (int o = 1; o < 64; o <<= 1) v = fmaxf(v, __shfl_xor(v, o));
    return v;
}
__device__ __forceinline__ float sum8(float v) { v += __shfl_xor(v, 1); v += __shfl_xor(v, 2); v += __shfl_xor(v, 4); return v; }
__device__ __forceinline__ float sigmoidf_(float x) { return 1.f / (1.f + __expf(-x)); }

__device__ __forceinline__ void mod_phase(const AV& a, LAS unsigned char* lds) {
    const int tid = otid(a), lane = tid & 63, wave = tid >> 6;
    LAS float* sl = (LAS float*)lds;
    LAS float* red = (LAS float*)(lds + 36864);
    for (int i = tid; i < 9 * 1024; i += NTHR) { const float v = (i < 8192) ? a.in(I_C)[i] : a.in(I_CCTX)[i - 8192]; sl[i] = v / (1.f + __expf(-v)); }
    __syncthreads();
    float* MOD = (float*)(a.ws() + WS_MOD);
    for (int it = obid(); it < 4 * 96; it += gridDim.x) {
        const int layer = it / 96, cgp = it % 96;
        const float* W = a.in(I_WADA) + (size_t)layer * 1024 * 6144 + cgp * 64 + lane;
        float acc[9];
#pragma unroll
        for (int r = 0; r < 9; ++r) acc[r] = 0.f;
        const int k0 = wave * 128;
#pragma unroll 8
        for (int k = 0; k < 128; ++k) {
            const float w = W[(size_t)(k0 + k) * 6144];
#pragma unroll
            for (int r = 0; r < 9; ++r) acc[r] += sl[r * 1024 + k0 + k] * w;
        }
#pragma unroll
        for (int r = 0; r < 9; ++r) red[(wave * 9 + r) * 64 + lane] = acc[r];
        __syncthreads();
        for (int o = tid; o < 576; o += NTHR) {
            const int r = o >> 6, cl = o & 63; float s = 0.f;
#pragma unroll
            for (int w = 0; w < 8; ++w) s += red[(w * 9 + r) * 64 + cl];
            const int col = cgp * 64 + cl;
            MOD[(size_t)(layer * 9 + r) * 6144 + col] = s + a.in(I_BADA)[layer * 6144 + col];
        }
        __syncthreads();
    }
}
__device__ __forceinline__ void rope_phase(const AV& a) {
    float2* R = (float2*)(a.ws() + WS_ROPE);
    for (int i = obid() * NTHR + otid(a); i < SEQ * 32; i += gridDim.x * NTHR) {
        const int t = i >> 5, f = i & 31; const float pos = (float)((f < 16) ? (t >> 6) : (t & 63));
        const float inv = exp2f(-(float)(f & 15) * 0.8304820237218406f);
        const float ang = pos * inv; const float k = rintf(ang * 0.15915494309189535f);
        float r = fmaf(-k, 6.28125f, ang); r = fmaf(-k, 0.0019353071795864769f, r);
        R[i] = make_float2(cosf(r), sinf(r));
    }
}

__device__ __forceinline__ void transpose_item(const float* W, int K, int N, bf16_t* WT, LAS float* scr, int item, int lane) {
    const int nblk = N / 32, kb = item / nblk, nb = item % nblk, k0 = 64 * kb, n0 = 32 * nb;
#pragma unroll 8
    for (int i = 0; i < 32; ++i) { const int kk = 2 * i + (lane >> 5); scr[kk * 33 + (lane & 31)] = W[(size_t)(k0 + kk) * N + n0 + (lane & 31)]; }
    asm volatile("s_waitcnt lgkmcnt(0)" ::: "memory");
    const int c = lane & 7;
#pragma unroll
    for (int j = 0; j < 4; ++j) { const int n = (lane >> 3) + 8 * j; const LAS float* s = scr + (8 * c) * 33 + n;
        uint4 o; o.x = pk2(s[0 * 33], s[1 * 33]); o.y = pk2(s[2 * 33], s[3 * 33]); o.z = pk2(s[4 * 33], s[5 * 33]); o.w = pk2(s[6 * 33], s[7 * 33]);
        *(uint4*)(WT + (size_t)(n0 + n) * K + k0 + 8 * c) = o; }
    asm volatile("s_waitcnt lgkmcnt(0)" ::: "memory");
}
__device__ __forceinline__ void wconv_phase(const AV& a, LAS unsigned char* lds, int layer) {
    const int tid = otid(a), lane = tid & 63, wave = tid >> 6;
    LAS float* scr = (LAS float*)(lds + 65536 + wave * 8704);
    const int gw = obid() * NWAVES + wave, NGW = gridDim.x * NWAVES;
    const bool even = (layer & 1) == 0; const int j = layer >> 1;
    const int NIN = even ? 2688 : 2304;
    const float* Win = even ? a.in(I_WINE) + (size_t)j * D * 2688 : a.in(I_WINO) + (size_t)j * D * 2304;
    bf16_t* WinT = (bf16_t*)(a.ws() + WS_W + W_IN); bf16_t* WoT = (bf16_t*)(a.ws() + WS_W + W_OUT); bf16_t* W1T = (bf16_t*)(a.ws() + WS_W + W_1); bf16_t* W2T = (bf16_t*)(a.ws() + WS_W + W_2);
    const int I_in = (D / 64) * (NIN / 32), I_o = (D / 64) * (D / 32), I_1 = (D / 64) * (FF / 32), I_2 = (FF / 64) * (D / 32);
    const int NIT = I_in + I_o + I_1 + I_2;
    for (int it = gw; it < NIT; it += NGW) {
        int r = it;
        if (r < I_in) { transpose_item(Win, D, NIN, WinT, scr, r, lane); continue; } r -= I_in;
        if (r < I_o) { transpose_item(a.in(I_WOUT) + (size_t)layer * D * D, D, D, WoT, scr, r, lane); continue; } r -= I_o;
        if (r < I_1) { transpose_item(a.in(I_WFF1) + (size_t)layer * D * FF, D, FF, W1T, scr, r, lane); continue; } r -= I_1;
        transpose_item(a.in(I_WFF2) + (size_t)layer * FF * D, FF, D, W2T, scr, r, lane);
    }
    if (even) {
        uint4* z = (uint4*)(WinT + (size_t)2688 * D);
        for (int i = obid() * NTHR + tid; i < 128 * D / 8; i += gridDim.x * NTHR) z[i] = make_uint4(0, 0, 0, 0);
        bf16_t* LT = (bf16_t*)(a.ws() + WS_W + W_L);
        const float* w2 = a.in(I_W2) + (size_t)j * 2 * 64 * 512; const float* a2 = a.in(I_A2) + (size_t)j * 2 * 64 * 512; const float* g2 = a.in(I_G2) + (size_t)j * 128 * 512;
        for (int i = obid() * NTHR + tid; i < 2560 * 384; i += gridDim.x * NTHR) {
            const int n = i / 384, k = i % 384; const int arr = n >> 9, ch = n & 511; float v = 0.f;
            if (arr < 2) { if ((k >> 6) == arr) v = w2[((size_t)arr * 64 + (k & 63)) * 512 + ch]; }
            else if (arr < 4) { if ((k >> 6) == arr) v = a2[((size_t)(arr - 2) * 64 + (k & 63)) * 512 + ch]; }
            else { if (k >= 256) v = g2[(size_t)(k - 256) * 512 + ch]; }
            LT[i] = (bf16_t)f2bf(v);
        }
    }
}

struct NormJob {
    int rows;
    const float* o_src;
    const float* gate; const float* gpost;
    bool h_in_input; bool write_h;
    const float* shift; const float* scale; const float* gpre;
};
__device__ __forceinline__ void norm_phase(const AV& a, const NormJob& jb) {
    const int tid = otid(a), lane = tid & 63, wave = tid >> 6;
    const int gw = obid() * NWAVES + wave, NGW = gridDim.x * NWAVES;
    float* hctx = (float*)(a.ws() + WS_HCTX); bf16_t* U = (bf16_t*)(a.ws() + WS_UMIX);
    for (int m = gw; m < jb.rows; m += NGW) {
        const int mb = (m < ML) ? (m >> 11) : 8;
        const float* hin = jb.h_in_input ? ((m < ML) ? a.in(I_X) + (size_t)m * D : a.in(I_CTX) + (size_t)(m - ML) * D)
                                         : ((m < ML) ? a.out() + (size_t)m * D : hctx + (size_t)(m - ML) * D);
        float* hout = (m < ML) ? a.out() + (size_t)m * D : hctx + (size_t)(m - ML) * D;
        f32x4 h[4];
#pragma unroll
        for (int q = 0; q < 4; ++q) h[q] = *(const f32x4*)(hin + 4 * lane + 256 * q);
        if (jb.o_src) {
            f32x4 o[4]; float ss = 0.f;
#pragma unroll
            for (int q = 0; q < 4; ++q) { o[q] = *(const f32x4*)(jb.o_src + (size_t)m * D + 4 * lane + 256 * q); ss += (o[q][0] * o[q][0] + o[q][1] * o[q][1]) + (o[q][2] * o[q][2] + o[q][3] * o[q][3]); }
            const float rms = rsqrtf(wave_sum(ss) * (1.f / D) + NORM_EPS);
#pragma unroll
            for (int q = 0; q < 4; ++q) {
                const f32x4 g = *(const f32x4*)(jb.gate + (size_t)mb * 6144 + 4 * lane + 256 * q), gp = *(const f32x4*)(jb.gpost + 4 * lane + 256 * q);
                h[q] = h[q] + g * (o[q] * rms * gp);
            }
        }
        if (jb.write_h) {
#pragma unroll
            for (int q = 0; q < 4; ++q) *(f32x4*)(hout + 4 * lane + 256 * q) = h[q];
        }
        if (jb.gpre) {
            float ss = 0.f;
#pragma unroll
            for (int q = 0; q < 4; ++q) ss += (h[q][0] * h[q][0] + h[q][1] * h[q][1]) + (h[q][2] * h[q][2] + h[q][3] * h[q][3]);
            const float rms = rsqrtf(wave_sum(ss) * (1.f / D) + NORM_EPS);
#pragma unroll
            for (int q = 0; q < 4; ++q) {
                const int col = 4 * lane + 256 * q;
                const f32x4 gp = *(const f32x4*)(jb.gpre + col), sc = *(const f32x4*)(jb.scale + (size_t)mb * 6144 + col), sh = *(const f32x4*)(jb.shift + (size_t)mb * 6144 + col);
                const f32x4 u = (h[q] * rms * gp) * (sc + 1.f) + sh;
                uint2 w; w.x = pk2(u[0], u[1]); w.y = pk2(u[2], u[3]);
                *(uint2*)(U + (size_t)m * D + col) = w;
            }
        }
    }
}

__device__ __forceinline__ void prep1_phase(const AV& a, int j) {
    const int tid = otid(a), lane = tid & 63, wave = tid >> 6;
    const int gw = obid() * NWAVES + wave, NGW = gridDim.x * NWAVES;
    const bf16_t* P = (const bf16_t*)(a.ws() + WS_A);
    bf16_t* RB = (bf16_t*)(a.ws() + WS_B); bf16_t* KB = RB + TOK512; bf16_t* VB = RB + 2 * TOK512; bf16_t* KKB = RB + 3 * TOK512;
    bf16_t* LA = (bf16_t*)(a.ws() + WS_UMIX);
    bf16_t* QKVB = (bf16_t*)(a.ws() + WS_QKVB);
    const float2* ROPE = (const float2*)(a.ws() + WS_ROPE);
    const float* mup = a.in(I_MUP) + j * AIN; const float* mun = a.in(I_MUN) + j * AIN; const float* k_k = a.in(I_KK) + j * 512;
    for (int m = gw; m < MT; m += NGW) {
        int t, len; if (m < ML) { t = m & (SEQ - 1); len = SEQ; } else { t = (m - ML) & (CTXL - 1); len = CTXL; }
        const bool hasp = t > 0, hasn = t < len - 1;
        const bf16_t* row = P + (size_t)m * NPE;
#pragma unroll
        for (int ps = 0; ps < 4; ++ps) {
            const int col = ps * 512 + lane * 8;
            const bool act = (ps < 3) || (lane < 48);
            float x[8];
            if (act) {
                float c[8], p[8], n[8], mp[8], mn[8];
                unpack8(*(const uint4*)(row + col), c);
                if (hasp) unpack8(*(const uint4*)(row - NPE + col), p); else {
#pragma unroll
                    for (int e = 0; e < 8; ++e) p[e] = 0.f; }
                if (hasn) unpack8(*(const uint4*)(row + NPE + col), n); else {
#pragma unroll
                    for (int e = 0; e < 8; ++e) n[e] = 0.f; }
                ld8f(mup + col, mp); ld8f(mun + col, mn);
#pragma unroll
                for (int e = 0; e < 8; ++e) x[e] = c[e] + mp[e] * (p[e] - c[e]) + mn[e] * (n[e] - c[e]);
            } else {
#pragma unroll
                for (int e = 0; e < 8; ++e) x[e] = 0.f;
            }
            if (ps == 0) *(uint4*)(RB + (size_t)m * 512 + lane * 8) = pack8(x);
            if (ps == 1) {
                *(uint4*)(KB + (size_t)m * 512 + lane * 8) = pack8(x);
                float kkv[8], kw[8]; ld8f(k_k + lane * 8, kw); float ss = 0.f;
#pragma unroll
                for (int e = 0; e < 8; ++e) { kkv[e] = x[e] * kw[e]; ss += kkv[e] * kkv[e]; }
                ss = sum8(ss);
                const float inv = 1.f / fmaxf(sqrtf(ss), 1e-12f);
#pragma unroll
                for (int e = 0; e < 8; ++e) kkv[e] *= inv;
                *(uint4*)(KKB + (size_t)m * 512 + lane * 8) = pack8(kkv);
            }
            if (ps == 2) *(uint4*)(VB + (size_t)m * 512 + lane * 8) = pack8(x);
            if (ps == 3 && act) {
                float y[8];
#pragma unroll
                for (int e = 0; e < 8; ++e) {
                    if (lane < 16) { const float ex = __expf(2.f * x[e]); y[e] = 1.f - 2.f / (ex + 1.f); }
                    else if (lane < 32) y[e] = x[e];
                    else y[e] = sigmoidf_(x[e]);
                }
                *(uint4*)(LA + (size_t)m * 1024 + lane * 8) = pack8(y);
            }
        }
#pragma unroll
        for (int ps = 0; ps < 2; ++ps) {
            const bool act = (ps == 0) || (lane < 32);
            const int col = (ps == 0 ? 1920 : 2432) + lane * 8;
            float x[8];
            if (act) unpack8(*(const uint4*)(row + col), x); else {
#pragma unroll
                for (int e = 0; e < 8; ++e) x[e] = 0.f; }
            float xp[8];
#pragma unroll
            for (int e = 0; e < 8; ++e) xp[e] = __shfl_xor(x[e], 2);
            const bool roped = (m < ML) && (ps == 0 || lane < 16);
            if (roped) {
                const int c8 = lane & 7; const float2* tab = ROPE + (size_t)t * 32 + 16 * (c8 >> 2) + 8 * (c8 & 1);
#pragma unroll
                for (int e = 0; e < 8; ++e) { const float2 cs = tab[e]; x[e] = (c8 & 2) ? (xp[e] * cs.y + x[e] * cs.x) : (x[e] * cs.x - xp[e] * cs.y); }
            }
            if (act) *(uint4*)(QKVB + (size_t)m * 768 + (ps == 0 ? 0 : 512) + lane * 8) = pack8(x);
        }
    }
}

__device__ __forceinline__ void qknorm_phase(const AV& a, int j) {
    const int tid = otid(a), lane = tid & 63, wave = tid >> 6;
    const int gw = obid() * NWAVES + wave, NGW = gridDim.x * NWAVES;
    bf16_t* P = (bf16_t*)(a.ws() + WS_A);
    const float2* ROPE = (const float2*)(a.ws() + WS_ROPE);
    const float* qg = a.in(I_QG) + j * 64; const float* kg = a.in(I_KG) + j * 64;
    for (int m = gw; m < MT; m += NGW) {
        const int t = m & (SEQ - 1);
        bf16_t* row = P + (size_t)m * NPO;
#pragma unroll
        for (int ps = 0; ps < 2; ++ps) {
            const bool act = (ps == 0) || (lane < 16);
            const int col = (ps == 0 ? 1536 : 2048) + lane * 8;
            float x[8];
            if (act) unpack8(*(const uint4*)(row + col), x); else {
#pragma unroll
                for (int e = 0; e < 8; ++e) x[e] = 0.f; }
            float ss = 0.f;
#pragma unroll
            for (int e = 0; e < 8; ++e) ss += x[e] * x[e];
            ss = sum8(ss);
            const float rms = rsqrtf(ss * (1.f / 64.f) + NORM_EPS);
            float g[8]; ld8f((ps == 0 ? qg : kg) + (lane & 7) * 8, g);
#pragma unroll
            for (int e = 0; e < 8; ++e) x[e] = x[e] * rms * g[e];
            float xp[8];
#pragma unroll
            for (int e = 0; e < 8; ++e) xp[e] = __shfl_xor(x[e], 2);
            if (m < ML) {
                const int c8 = lane & 7; const float2* tab = ROPE + (size_t)t * 32 + 16 * (c8 >> 2) + 8 * (c8 & 1);
#pragma unroll
                for (int e = 0; e < 8; ++e) { const float2 cs = tab[e]; x[e] = (c8 & 2) ? (xp[e] * cs.y + x[e] * cs.x) : (x[e] * cs.x - xp[e] * cs.y); }
            }
            if (act) *(uint4*)(row + col) = pack8(x);
        }
    }
}

__device__ __forceinline__ void rwkv_out_phase(const AV& a, int j) {
    const int tid = otid(a), lane = tid & 63, wave = tid >> 6;
    const int gw = obid() * NWAVES + wave, NGW = gridDim.x * NWAVES;
    const float* Y0 = (const float*)(a.ws() + WS_B + B_Y0); const float* Y1 = (const float*)(a.ws() + WS_B + B_Y1);
    const bf16_t* LR = (const bf16_t*)(a.ws() + WS_A);
    const bf16_t* RB = (const bf16_t*)(a.ws() + WS_B); const bf16_t* KB = RB + TOK512; const bf16_t* VB = RB + 2 * TOK512;
    bf16_t* MIX = (bf16_t*)(a.ws() + WS_UMIX);
    const float* k_a = a.in(I_KA) + j * 512; const float* r_k = a.in(I_RK) + j * 512; const float* gnw = a.in(I_GNW) + j * 512; const float* gnb = a.in(I_GNB) + j * 512;
    const int ch = lane * 8;
    float ka[8], rk[8], gw8[8], gb8[8], ab0[8], ab1[8]; ld8f(k_a + ch, ka); ld8f(r_k + ch, rk); ld8f(gnw + ch, gw8); ld8f(gnb + ch, gb8);
    ld8f(a.in(I_A0) + j * 1024 + ch, ab0); ld8f(a.in(I_A0) + j * 1024 + 512 + ch, ab1);
    for (int m = gw; m < MT; m += NGW) {
        const size_t o = (size_t)m * 512 + ch;
        float y[8], y1[8]; ld8f(Y0 + o, y); ld8f(Y1 + o, y1);
        float s = 0.f;
#pragma unroll
        for (int e = 0; e < 8; ++e) { y[e] += y1[e]; s += y[e]; }
        const float mu = sum8(s) * (1.f / 64.f); float q = 0.f;
#pragma unroll
        for (int e = 0; e < 8; ++e) { y[e] -= mu; q += y[e] * y[e]; }
        const float rstd = rsqrtf(sum8(q) * (1.f / 64.f) + GN_EPS);
        float r[8], k[8], v[8], a0[8], a1[8], g[8];
        unpack8(*(const uint4*)(RB + o), r); unpack8(*(const uint4*)(KB + o), k); unpack8(*(const uint4*)(VB + o), v);
        const bf16_t* lr = LR + (size_t)m * NLR + ch;
        unpack8(*(const uint4*)(lr + 1024), a0); unpack8(*(const uint4*)(lr + 1536), a1); unpack8(*(const uint4*)(lr + 2048), g);
#pragma unroll
        for (int e = 0; e < 8; ++e) { a0[e] = sigmoidf_(a0[e] + ab0[e]); a1[e] = sigmoidf_(a1[e] + ab1[e]); }
        float bs = 0.f;
#pragma unroll
        for (int e = 0; e < 8; ++e) { const float kd = k[e] * (1.f + (a0[e] - 1.f) * ka[e]) + k[e] * (1.f + (a1[e] - 1.f) * ka[e]); bs += r[e] * kd * rk[e]; }
        bs = sum8(bs);
        float outv[8];
#pragma unroll
        for (int e = 0; e < 8; ++e) outv[e] = (y[e] * rstd * gw8[e] + gb8[e] + bs * v[e]) * g[e];
        *(uint4*)(MIX + (size_t)m * 1024 + ch) = pack8(outv);
    }
}

__device__ __forceinline__ void scan_naive_phase(const AV& a, int j) {
    const int tid = otid(a), lane = tid & 63, wave = tid >> 6;
    const int gw = obid() * NWAVES + wave, NGW = gridDim.x * NWAVES;
    const bf16_t* RB = (const bf16_t*)(a.ws() + WS_B); const bf16_t* KB = RB + TOK512; const bf16_t* VB = RB + 2 * TOK512; const bf16_t* KKB = RB + 3 * TOK512;
    for (int cq = gw; cq < 512; cq += NGW) {
        const int cb = cq >> 2, rq = cq & 3;
        const int dir = cb & 1, h = (cb >> 1) & 7, b = cb >> 4;
        const int row = rq * 16 + (lane >> 2), part = lane & 3;
        const bf16_t* LR = (const bf16_t*)(a.ws() + WS_A) + dir * 512 + h * 64 + part * 16;
        float* Y = (float*)(a.ws() + WS_B + (dir ? B_Y1 : B_Y0));
        float w0[16], a0[16];
        ld8f(a.in(I_W0) + j * 1024 + dir * 512 + h * 64 + part * 16, *(float(*)[8])&w0[0]); ld8f(a.in(I_W0) + j * 1024 + dir * 512 + h * 64 + part * 16 + 8, *(float(*)[8])&w0[8]);
        ld8f(a.in(I_A0) + j * 1024 + dir * 512 + h * 64 + part * 16, *(float(*)[8])&a0[0]); ld8f(a.in(I_A0) + j * 1024 + dir * 512 + h * 64 + part * 16 + 8, *(float(*)[8])&a0[8]);
        float ka[16]; ld8f(a.in(I_KA) + j * 512 + h * 64 + part * 16, *(float(*)[8])&ka[0]); ld8f(a.in(I_KA) + j * 512 + h * 64 + part * 16 + 8, *(float(*)[8])&ka[8]);
        float S[16];
#pragma unroll
        for (int k = 0; k < 16; ++k) S[k] = 0.f;
        for (int s = 0; s < CTXL + SEQ; ++s) {
            int m;
            if (s < CTXL) m = ML + b * CTXL + (dir ? (CTXL - 1 - s) : s);
            else m = b * SEQ + (dir ? (SEQ - 1 - (s - CTXL)) : (s - CTXL));
            const size_t oh = (size_t)m * 512 + h * 64, o = oh + part * 16;
            const float vv = bf1(VB[oh + row]);
            float kk[16], ee[16], ai[16], kx[16], rr[16];
            unpack8(*(const uint4*)(KKB + o), *(float(*)[8])&kk[0]); unpack8(*(const uint4*)(KKB + o + 8), *(float(*)[8])&kk[8]);
            const bf16_t* lr = LR + (size_t)m * NLR;
            unpack8(*(const uint4*)(lr), *(float(*)[8])&ee[0]);  unpack8(*(const uint4*)(lr + 8), *(float(*)[8])&ee[8]);
            unpack8(*(const uint4*)(lr + 1024), *(float(*)[8])&ai[0]);  unpack8(*(const uint4*)(lr + 1032), *(float(*)[8])&ai[8]);
#pragma unroll
            for (int k = 0; k < 16; ++k) { ee[k] = 0.60653065971263342f * sigmoidf_(ee[k] + w0[k]); ai[k] = sigmoidf_(ai[k] + a0[k]); }
            unpack8(*(const uint4*)(KB + o), *(float(*)[8])&kx[0]);  unpack8(*(const uint4*)(KB + o + 8), *(float(*)[8])&kx[8]);
            unpack8(*(const uint4*)(RB + o), *(float(*)[8])&rr[0]);  unpack8(*(const uint4*)(RB + o + 8), *(float(*)[8])&rr[8]);
            float d = 0.f;
#pragma unroll
            for (int k = 0; k < 16; ++k) d += S[k] * kk[k];
            d += __shfl_xor(d, 1); d += __shfl_xor(d, 2);
            const float sa = -d;
            float y = 0.f;
#pragma unroll
            for (int k = 0; k < 16; ++k) {
                const float w = __expf(-ee[k]), bb = kk[k] * ai[k], kd = kx[k] * (1.f + (ai[k] - 1.f) * ka[k]);
                const float sn = S[k] * w + sa * bb + vv * kd;
                S[k] = sn; y += sn * rr[k];
            }
            y += __shfl_xor(y, 1); y += __shfl_xor(y, 2);
            if (part == 0) Y[oh + row] = y;
        }
    }
}

template <class KF> __device__ __forceinline__ void attn_naive_row(const bf16_t* qp, const KF& kf, int nkeys, bool has_sink, float sink, bf16_t* outp, int lane) {
    float q[64];
#pragma unroll
    for (int c = 0; c < 8; ++c) { float t8[8]; unpack8(*(const uint4*)(qp + c * 8), t8);
#pragma unroll
        for (int e = 0; e < 8; ++e) q[c * 8 + e] = t8[e]; }
    float mrun = -1e30f, lrun = 0.f; float o[64];
#pragma unroll
    for (int d = 0; d < 64; ++d) o[d] = 0.f;
    for (int j = lane; j < nkeys; j += 64) {
        const bf16_t* kp; const bf16_t* vp; float bias;
        if (!kf(j, kp, vp, bias)) continue;
        float s = 0.f;
#pragma unroll
        for (int c = 0; c < 8; ++c) { float t8[8]; unpack8(*(const uint4*)(kp + c * 8), t8);
#pragma unroll
            for (int e = 0; e < 8; ++e) s += q[c * 8 + e] * t8[e]; }
        s = s * 0.125f + bias;
        const float mn = fmaxf(mrun, s), al = __expf(mrun - mn), p = __expf(s - mn);
        lrun = lrun * al + p; mrun = mn;
#pragma unroll
        for (int c = 0; c < 8; ++c) { float t8[8]; unpack8(*(const uint4*)(vp + c * 8), t8);
#pragma unroll
            for (int e = 0; e < 8; ++e) o[c * 8 + e] = o[c * 8 + e] * al + p * t8[e]; }
    }
    float M = wave_max(mrun); if (has_sink) M = fmaxf(M, sink);
    const float sc = __expf(mrun - M);
    const float L = wave_sum(lrun * sc) + (has_sink ? __expf(sink - M) : 0.f);
    float res = 0.f;
#pragma unroll
    for (int d = 0; d < 64; ++d) { const float v = wave_sum(o[d] * sc); if (lane == d) res = v; }
    outp[lane] = (bf16_t)f2bf(res / L);
}

struct KfB {
    const bf16_t* QKVB; int b, t, kvh; bool ctxq;
    __device__ __forceinline__ bool operator()(int j, const bf16_t*& kp, const bf16_t*& vp, float& bias) const {
        bias = 0.f; size_t row;
        if (ctxq) row = (size_t)ML + b * CTXL + j;
        else if (j < 257) { const int kpos = t - 128 + j; if (kpos < 0 || kpos >= SEQ) return false; row = (size_t)b * SEQ + kpos; }
        else row = (size_t)ML + b * CTXL + (j - 257);
        kp = QKVB + row * 768 + 512 + kvh * 64; vp = kp + 128; return true;
    }
};
struct KfC {
    const bf16_t* P; const float* rpb; int b, r, c, h; bool ctxq;
    __device__ __forceinline__ bool operator()(int j, const bf16_t*& kp, const bf16_t*& vp, float& bias) const {
        size_t row; bias = 0.f;
        if (ctxq) row = (size_t)ML + b * CTXL + j;
        else if (j < 128) {
            const int i = j >> 4, jj = j & 15;
            const int kr = min(max(r - 4, 0), 24) + i, kc = min(max(c - 8, 0), 48) + jj;
            const int dr = kr - r + 7, dc = min(max(kc - c + 15, 0), 30);
            bias = rpb[(h * 15 + dr) * 31 + dc];
            row = (size_t)b * SEQ + kr * 64 + kc;
        } else row = (size_t)ML + b * CTXL + (j - 128);
        kp = P + row * NPO + 512 + h * 64; vp = kp + 512; return true;
    }
};
struct KfD {
    const bf16_t* P; int b, kvh; bool ctxq;
    __device__ __forceinline__ bool operator()(int j, const bf16_t*& kp, const bf16_t*& vp, float& bias) const {
        bias = 0.f; const size_t row = (j < CTXL) ? (size_t)ML + b * CTXL + j : (size_t)b * SEQ + (j - CTXL);
        kp = P + row * NPO + 2048 + kvh * 64; vp = kp + 128; return true;
    }
};

__device__ __forceinline__ void attnB_naive_phase(const AV& a, int j, bool need_ctx) {
    const int tid = otid(a), lane = tid & 63, wave = tid >> 6;
    const int gw = obid() * NWAVES + wave, NGW = gridDim.x * NWAVES;
    const bf16_t* QKVB = (const bf16_t*)(a.ws() + WS_QKVB); bf16_t* MIX = (bf16_t*)(a.ws() + WS_UMIX);
    const int rows = need_ctx ? MT : ML;
    for (int it = gw; it < rows * 8; it += NGW) {
        const int m = it >> 3, hq = it & 7;
        KfB kf; kf.QKVB = QKVB; kf.kvh = hq >> 2; kf.ctxq = m >= ML;
        if (m < ML) { kf.b = m >> 11; kf.t = m & (SEQ - 1); } else { kf.b = (m - ML) >> 8; kf.t = 0; }
        attn_naive_row(QKVB + (size_t)m * 768 + hq * 64, kf, kf.ctxq ? CTXL : 257 + CTXL, true, a.in(I_SINK)[j * 8 + hq], MIX + (size_t)m * 1024 + 512 + hq * 64, lane);
    }
}
__device__ __forceinline__ void attnCD_naive_phase(const AV& a, int j, bool need_ctx) {
    const int tid = otid(a), lane = tid & 63, wave = tid >> 6;
    const int gw = obid() * NWAVES + wave, NGW = gridDim.x * NWAVES;
    const bf16_t* P = (const bf16_t*)(a.ws() + WS_A); bf16_t* MIX = (bf16_t*)(a.ws() + WS_UMIX);
    const int rows = need_ctx ? MT : ML;
    for (int it = gw; it < rows * 16; it += NGW) {
        const int m = it >> 4, hh = it & 15;
        const bool ctxq = m >= ML; const int b = ctxq ? (m - ML) >> 8 : m >> 11; const int t = m & (SEQ - 1);
        if (hh < 8) {
            KfC kf; kf.P = P; kf.rpb = a.in(I_RPB) + (size_t)j * 8 * 15 * 31; kf.b = b; kf.r = t >> 6; kf.c = t & 63; kf.h = hh; kf.ctxq = ctxq;
            attn_naive_row(P + (size_t)m * NPO + hh * 64, kf, ctxq ? CTXL : 128 + CTXL, false, 0.f, MIX + (size_t)m * 1024 + hh * 64, lane);
        } else {
            const int hq = hh - 8;
            KfD kf; kf.P = P; kf.b = b; kf.kvh = hq >> 2; kf.ctxq = ctxq;
            attn_naive_row(P + (size_t)m * NPO + 1536 + hq * 64, kf, ctxq ? CTXL : CTXL + SEQ, false, 0.f, MIX + (size_t)m * 1024 + 512 + hq * 64, lane);
        }
    }
}

enum { OP_SETUP = 0, OP_NORM0, OP_GEMM_IN, OP_PREP1, OP_GEMM_LORA, OP_SCAN, OP_RWKVOUT, OP_QKNORM, OP_ATTNCD, OP_GEMM_OUT, OP_NORM_H, OP_GEMM_FF1, OP_GEMM_FF2, OP_NORM_K };
__device__ __forceinline__ void decode_phase(int ph, int& layer, int& op) {
    if (ph < 2) { layer = 0; op = ph; return; }
    int r = ph - 2; layer = 0;
    if (r >= 10) { r -= 10; layer = 1; if (r >= 8) { r -= 8; layer = 2; if (r >= 10) { r -= 10; layer = 3; } } }
    if ((layer & 1) == 0) { const int t[10] = {OP_GEMM_IN, OP_PREP1, OP_GEMM_LORA, OP_SCAN, OP_RWKVOUT, OP_GEMM_OUT, OP_NORM_H, OP_GEMM_FF1, OP_GEMM_FF2, OP_NORM_K}; op = OP_GEMM_IN;
#pragma unroll
        for (int q = 0; q < 10; ++q) if (r == q) op = t[q]; }
    else { const int t[8] = {OP_GEMM_IN, OP_QKNORM, OP_ATTNCD, OP_GEMM_OUT, OP_NORM_H, OP_GEMM_FF1, OP_GEMM_FF2, OP_NORM_K}; op = OP_GEMM_IN;
#pragma unroll
        for (int q = 0; q < 8; ++q) if (r == q) op = t[q]; }
}
__global__ void __launch_bounds__(NTHR, 2) trunk_fwd(Args a_) {
    extern __shared__ __attribute__((aligned(16))) unsigned char lds_raw[];
    LAS unsigned char* lds = (LAS unsigned char*)lds_raw;
    cg::grid_group grid = cg::this_grid();
    const int lo = a_.ph_lo, hi = a_.ph_hi;
    const int wv_ = __builtin_amdgcn_readfirstlane((int)threadIdx.x >> 6);
    const int G = gridDim.x;
    for (int ph = lo; ph < hi; ++ph) {
        int z_; asm volatile("s_mov_b32 %0, 0" : "=s"(z_)); const AV a{a_, z_, wv_};
        int layer, op; decode_phase(ph, layer, op);
        const bool even = (layer & 1) == 0; const int j = layer >> 1; const bool need_ctx = layer < 3;
        const int Mrows = need_ctx ? MT : ML;
        float* MOD = (float*)(a.ws() + WS_MOD); const float* modl = MOD + (size_t)layer * 9 * 6144;
        bf16_t* UMIX = (bf16_t*)(a.ws() + WS_UMIX);
        if (op == OP_SETUP) { mod_phase(a, lds); rope_phase(a); wconv_phase(a, lds, 0); }
        else if (op == OP_NORM0 || op == OP_NORM_H || op == OP_NORM_K) {
            NormJob jb;
            if (op == OP_NORM0) { jb.rows = MT; jb.o_src = nullptr; jb.gate = nullptr; jb.gpost = nullptr; jb.h_in_input = true; jb.write_h = false;
                jb.shift = MOD + 0 * 1024; jb.scale = MOD + 1 * 1024; jb.gpre = a.in(I_GPREMIX); }
            else if (op == OP_NORM_H) { jb.rows = Mrows; jb.o_src = (const float*)(a.ws() + WS_A); jb.gate = modl + 2 * 1024; jb.gpost = a.in(I_GPOSTMIX) + layer * D;
                jb.h_in_input = (layer == 0); jb.write_h = true; jb.shift = modl + 3 * 1024; jb.scale = modl + 4 * 1024; jb.gpre = a.in(I_GPREFF) + layer * D; }
            else { jb.rows = Mrows; jb.o_src = (const float*)(a.ws() + WS_O2); jb.gate = modl + 5 * 1024; jb.gpost = a.in(I_GPOSTFF) + layer * D; jb.h_in_input = false; jb.write_h = true;
                if (layer < 3) { const float* modn = modl + 9 * 6144; jb.shift = modn + 0 * 1024; jb.scale = modn + 1 * 1024; jb.gpre = a.in(I_GPREMIX) + (layer + 1) * D; }
                else { jb.shift = nullptr; jb.scale = nullptr; jb.gpre = nullptr; } }
            norm_phase(a, jb);
            if (op == OP_NORM_K && layer < 3) wconv_phase(a, lds, layer + 1);
        }
        else if (op == OP_GEMM_IN || op == OP_GEMM_LORA || op == OP_GEMM_FF1) {
            pg8::Gemm g; bf16_t* O; int ldc;
            if (op == OP_GEMM_IN) { const int NP = even ? NPE : NPO; g = pg8::Gemm{UMIX, (const bf16_t*)(a.ws() + WS_W + W_IN), MT, NP, D, D}; O = (bf16_t*)(a.ws() + WS_A); ldc = NP; }
            else if (op == OP_GEMM_LORA) { g = pg8::Gemm{UMIX, (const bf16_t*)(a.ws() + WS_W + W_L), MT, NLR, 384, 1024}; O = (bf16_t*)(a.ws() + WS_A); ldc = NLR; }
            else { g = pg8::Gemm{UMIX, (const bf16_t*)(a.ws() + WS_W + W_1), Mrows, FF, D, D}; O = (bf16_t*)(a.ws() + WS_A); ldc = FF; }
            pg8::StaticOrder S; S.init(g.M, g.N, G, obid());
            pg8::EpiBf16 E{O, ldc, op == OP_GEMM_FF1};
            pg8::gemm_phase<pg8::EpiBf16, pg8::StaticOrder, true, true>(lds, g, S, E, otid(a));
        }
        else if (op == OP_GEMM_OUT || op == OP_GEMM_FF2) {
            pg8::Gemm g; float* O;
            if (op == OP_GEMM_OUT) { g = pg8::Gemm{UMIX, (const bf16_t*)(a.ws() + WS_W + W_OUT), Mrows, D, D, D}; O = (float*)(a.ws() + WS_A); }
            else { g = pg8::Gemm{(const bf16_t*)(a.ws() + WS_A), (const bf16_t*)(a.ws() + WS_W + W_2), Mrows, D, FF, FF}; O = (float*)(a.ws() + WS_O2); }
            pg8::StaticOrder S; S.init(g.M, g.N, G, obid());
            pg8::EpiF32 E{O, D};
            pg8::gemm_phase<pg8::EpiF32, pg8::StaticOrder, true, true>(lds, g, S, E, otid(a));
        }
        else if (op == OP_PREP1) prep1_phase(a, j);
        else if (op == OP_SCAN) { scan_naive_phase(a, j); attnB_naive_phase(a, j, need_ctx); }
        else if (op == OP_RWKVOUT) rwkv_out_phase(a, j);
        else if (op == OP_QKNORM) qknorm_phase(a, j);
        else if (op == OP_ATTNCD) attnCD_naive_phase(a, j, need_ctx);
        if (ph + 1 < hi) grid.sync();
    }
}

#ifndef N_LAUNCH_MODE
#define N_LAUNCH_MODE 1
#endif
extern "C" void kernel_launch(void* const* d_in, const int* in_sizes, int n_in, void* d_out, int out_size, void* d_ws, size_t ws_size, hipStream_t stream) {
    static int grid = 0;
    if (grid == 0) {
        if (n_in != N_IN || out_size != ML * D || ws_size < WS_END) { fprintf(stderr, "kernel_launch: unexpected shapes (n_in %d out %d ws %zu need %zu)\n", n_in, out_size, ws_size, (size_t)WS_END); grid = -1; return; }
        int dev = 0, cus = 0, per_cu = 0;
        (void)hipGetDevice(&dev); (void)hipDeviceGetAttribute(&cus, hipDeviceAttributeMultiprocessorCount, dev);
        (void)hipFuncSetAttribute((const void*)trunk_fwd, hipFuncAttributeMaxDynamicSharedMemorySize, LDS_BYTES);
        (void)hipOccupancyMaxActiveBlocksPerMultiprocessor(&per_cu, (const void*)trunk_fwd, NTHR, LDS_BYTES);
        if (per_cu < 1) per_cu = 1;
        grid = cus;
        fprintf(stderr, "kernel_launch: cus %d per_cu %d grid %d ws %zu\n", cus, per_cu, grid, ws_size);
    }
    if (grid < 0) return;
    Args a{};
    for (int i = 0; i < N_IN; ++i) a.in[i] = (const float*)d_in[i];
    a.out = (float*)d_out; a.ws = (unsigned char*)d_ws;
#if N_LAUNCH_MODE == 1
    a.ph_lo = 0; a.ph_hi = NPH;
    void* args[] = {&a};
    hipError_t e = hipLaunchCooperativeKernel((const void*)trunk_fwd, dim3(grid), dim3(NTHR), args, LDS_BYTES, stream);
    if (e != hipSuccess) fprintf(stderr, "cooperative launch failed: %s\n", hipGetErrorString(e));
#else
    for (int p = 0; p < NPH; ++p) { a.ph_lo = p; a.ph_hi = p + 1; hipLaunchKernelGGL(trunk_fwd, dim3(grid), dim3(NTHR), LDS_BYTES, stream, a); }
#endif
}
```

```cpp
#include <hip/hip_runtime.h>
#include <hip/hip_cooperative_groups.h>
#include <cstdio>
#include <cstdint>
namespace cg = cooperative_groups;

namespace pg8 {
#define PG8_LAS __attribute__((address_space(3)))
typedef unsigned short bf16_t;
typedef short bf16x8 __attribute__((ext_vector_type(8)));
typedef float f32x4 __attribute__((ext_vector_type(4)));
typedef unsigned u32x4 __attribute__((ext_vector_type(4)));
constexpr int BM = 256, BK = 64, HALF = 128, HTB = HALF * BK * 2  , STAGE_BYTES = 8 * HTB, NXCD = 8, WGM = 8;

__host__ __device__ __forceinline__ int lds_byte(int r, int c) { const int st = (r >> 4) * 2 + (c >> 5), rr = r & 15, cc = c & 31, ob = rr * 64 + cc * 2; return st * 1024 + (ob ^ (((ob >> 9) & 1) << 5)); }
__host__ __device__ __forceinline__ void stage_rc(int b, int& R, int& C) { const int st = b / 1024, sb = b % 1024, swz = sb ^ (((sb >> 9) & 1) << 5); R = (st >> 1) * 16 + swz / 64; C = (st & 1) * 32 + (swz % 64) / 2; }
__host__ __device__ __forceinline__ int perm32(int rho) { const int n = rho >> 4, i = rho & 15; return 8 * (i >> 2) + 4 * n + (i & 3); }

struct Unit { int pm, pn; };
struct Gemm { const bf16_t* A; const bf16_t* Bt; int M, N, K, lda; };

struct StaticOrder {
    int nM, nN, nwg, G, c;
    __host__ __device__ void init(int M, int N, int G_, int c_) { nM = M / BM; nN = N / BM; nwg = nM * nN; G = G_; c = c_; }
    __host__ __device__ bool next(int i, Unit& u) const {
        const long L = (long)i * G + c; if (L >= nwg) return false;
        int wgid = (int)L; { const int q = nwg / NXCD, r = nwg % NXCD, xcd = wgid % NXCD, off = wgid / NXCD; wgid = (xcd < r ? xcd * (q + 1) : r * (q + 1) + (xcd - r) * q) + off; }
        const int nig = WGM * nN, gid = wgid / nig, fm = gid * WGM, gsz = (nM - fm) < WGM ? (nM - fm) : WGM;
        u.pm = fm + ((wgid % nig) % gsz); u.pn = (wgid % nig) / gsz; return true;
    }
    __device__ __forceinline__ void a_ready(const Unit&) const {}
    __device__ __forceinline__ void done(const Unit&) const {}
};

__device__ __forceinline__ unsigned cvt_pk_bf16(float lo, float hi) { unsigned r; asm volatile("v_cvt_pk_bf16_f32 %0, %1, %2" : "=v"(r) : "v"(lo), "v"(hi)); return r; }

struct EpiBf16 {
    static constexpr bool PERM = true, AFTER_DRAIN = false;
    bf16_t* O; int ldc; bool sq;
    __device__ __forceinline__ void operator()(const f32x4 (&acc)[2][2][4][2], const Unit& u, int wr, int wc, int fr, int fq) const {
        const int row0 = u.pm * BM + wr * 64 + fr; const int col0 = u.pn * BM + wc * 32 + 8 * fq;
#pragma unroll
        for (int ai = 0; ai < 2; ++ai)
#pragma unroll
            for (int m = 0; m < 4; ++m) { bf16_t* rowp = O + (size_t)(row0 + ai * HALF + m * 16) * ldc + col0;
#pragma unroll
                for (int bj = 0; bj < 2; ++bj) { f32x4 v0 = acc[ai][bj][m][0], v1 = acc[ai][bj][m][1];
                    if (sq) {
#pragma unroll
                        for (int e = 0; e < 4; ++e) { float a = fmaxf(v0[e], 0.f), b = fmaxf(v1[e], 0.f); v0[e] = a * a; v1[e] = b * b; } }
                    u32x4 w; w.x = cvt_pk_bf16(v0[0], v0[1]); w.y = cvt_pk_bf16(v0[2], v0[3]); w.z = cvt_pk_bf16(v1[0], v1[1]); w.w = cvt_pk_bf16(v1[2], v1[3]);
                    *(u32x4*)(rowp + bj * HALF) = w; } }
    }
};

struct EpiF32 {
    static constexpr bool PERM = false, AFTER_DRAIN = false;
    float* C; int ldc;
    __device__ __forceinline__ void operator()(const f32x4 (&acc)[2][2][4][2], const Unit& u, int wr, int wc, int fr, int fq) const {
        const int row0 = u.pm * BM + wr * 64 + fr, col0 = u.pn * BM + wc * 32 + 4 * fq;
#pragma unroll
        for (int ai = 0; ai < 2; ++ai)
#pragma unroll
            for (int m = 0; m < 4; ++m) { float* rowp = C + (size_t)(row0 + ai * HALF + m * 16) * ldc + col0;
#pragma unroll
                for (int bj = 0; bj < 2; ++bj)
#pragma unroll
                    for (int n = 0; n < 2; ++n) *(f32x4*)(rowp + bj * HALF + n * 16) = acc[ai][bj][m][n]; }
    }
};


template <class Epi, class Sched, bool ALIGN_EPI = false, bool SP2 = false>
__device__ __forceinline__ void gemm_phase(PG8_LAS unsigned char* lds, const Gemm g, const Sched& S, const Epi& E, const int tid_in) {
    int tid_ = tid_in; asm volatile("" : "+v"(tid_));
    const int tid = tid_, wid = __builtin_amdgcn_readfirstlane(tid >> 6), lane = tid & 63, wr = wid >> 2, wc = wid & 3, fr = lane & 15, fq = lane >> 4;
    const int K = g.K, nt = K / BK;
    unsigned voffA[2], voffB[2];
#pragma unroll
    for (int i = 0; i < 2; ++i) { int R, C; stage_rc(tid * 16 + i * 8192, R, C); const int Rb = Epi::PERM ? ((R & ~31) + perm32(R & 31)) : R;
        voffA[i] = (unsigned)(R * g.lda + C) * 2u; voffB[i] = (unsigned)(Rb * K + C) * 2u; }
    const size_t kstep = (size_t)(BK * 2);
    const size_t hstepA = (size_t)HALF * g.lda * 2, hstepB = (size_t)HALF * K * 2;
    const size_t tstepA = 2 * hstepA, tstepB = 2 * hstepB;
    const unsigned ldsw = (unsigned)wid * 1024u;
    const int aoff = lds_byte(wr * 64 + fr, fq * 8), boff = lds_byte(wc * 32 + fr, fq * 8);
#define PG8_SA(b, h) (((b) * 2 + (h)) * HTB)
#define PG8_SB(b, h) ((4 + (b) * 2 + (h)) * HTB)
#define PG8_STAGE(bufoff, gbase, voff) do { _Pragma("unroll") for (int _i = 0; _i < 2; ++_i) \
        __builtin_amdgcn_global_load_lds((const unsigned*)((const char*)(gbase) + (voff)[_i]), (PG8_LAS unsigned*)(lds + (bufoff) + ldsw + _i * 8192), 16, 0, 0); } while (0)
#define PG8_LDA(dst, b, h) do { _Pragma("unroll") for (int m = 0; m < 4; ++m) _Pragma("unroll") for (int k = 0; k < 2; ++k) dst[m][k] = *(const PG8_LAS bf16x8*)(lds + PG8_SA(b, h) + aoff + m * 2048 + k * 1024); } while (0)
#define PG8_LDB(dst, b, h) do { _Pragma("unroll") for (int n = 0; n < 2; ++n) _Pragma("unroll") for (int k = 0; k < 2; ++k) dst[n][k] = *(const PG8_LAS bf16x8*)(lds + PG8_SB(b, h) + boff + n * 2048 + k * 1024); } while (0)
#define PG8_MMA(ai, bj, At, Bt) do { __builtin_amdgcn_s_setprio(1); _Pragma("unroll") for (int m = 0; m < 4; ++m) _Pragma("unroll") for (int n = 0; n < 2; ++n) _Pragma("unroll") for (int k = 0; k < 2; ++k) \
        acc[ai][bj][m][n] = __builtin_amdgcn_mfma_f32_16x16x32_bf16(Bt[n][k], At[m][k], acc[ai][bj][m][n], 0, 0, 0); __builtin_amdgcn_s_setprio(0); } while (0)
#define PG8_WAIT_V(n) asm volatile("s_waitcnt vmcnt(" #n ")" ::: "memory")
#define PG8_WAIT_L(n) asm volatile("s_waitcnt lgkmcnt(" #n ")" ::: "memory")
#define PG8_BAR __builtin_amdgcn_s_barrier()
#define PG8_SCHED __builtin_amdgcn_sched_barrier(0)
    Unit cur, nxt; int ui = 0;
    if (!S.next(0, cur)) return;
    f32x4 acc[2][2][4][2];
#pragma unroll
    for (int a = 0; a < 2; ++a)
#pragma unroll
        for (int b = 0; b < 2; ++b)
#pragma unroll
            for (int m = 0; m < 4; ++m)
#pragma unroll
                for (int n = 0; n < 2; ++n) acc[a][b][m][n] = (f32x4){0.f, 0.f, 0.f, 0.f};
    bf16x8 At[4][2], B0[2][2], B1[2][2];
    const char* cA = (const char*)g.A + (size_t)cur.pm * tstepA; const char* cB = (const char*)g.Bt + (size_t)cur.pn * tstepB;
    S.a_ready(cur);
    if constexpr (SP2) {
        PG8_STAGE(PG8_SB(0, 0), cB, voffB); PG8_STAGE(PG8_SB(0, 1), cB + hstepB, voffB); PG8_STAGE(PG8_SA(0, 0), cA, voffA); PG8_STAGE(PG8_SA(0, 1), cA + hstepA, voffA);
        if (wr == 1) PG8_BAR;
        PG8_WAIT_V(2); PG8_BAR;
        PG8_STAGE(PG8_SB(1, 0), cB + kstep, voffB); PG8_STAGE(PG8_SA(1, 0), cA + kstep, voffA); PG8_STAGE(PG8_SB(1, 1), cB + hstepB + kstep, voffB);
        PG8_WAIT_V(6); PG8_BAR;
    } else {
        PG8_STAGE(PG8_SB(0, 0), cB, voffB); PG8_STAGE(PG8_SA(0, 0), cA, voffA); PG8_STAGE(PG8_SB(0, 1), cB + hstepB, voffB); PG8_STAGE(PG8_SA(0, 1), cA + hstepA, voffA);
        if (wr == 1) PG8_BAR;
        PG8_WAIT_V(4); PG8_BAR;
        PG8_STAGE(PG8_SB(1, 0), cB + kstep, voffB); PG8_STAGE(PG8_SA(1, 0), cA + kstep, voffA); PG8_STAGE(PG8_SB(1, 1), cB + hstepB + kstep, voffB);
        PG8_WAIT_V(6); PG8_BAR;
    }
    for (;;) {
        const bool has_next = S.next(ui + 1, nxt);
        const char* nA = has_next ? (const char*)g.A + (size_t)nxt.pm * tstepA : cA; const char* nB = has_next ? (const char*)g.Bt + (size_t)nxt.pn * tstepB : cB;
        for (int t = 0; t < nt; t += 2) {
            const bool last = (t == nt - 2);
            const char* a1 = cA + (size_t)(t + 1) * kstep;
            const char* a2 = last ? nA : cA + (size_t)(t + 2) * kstep; const char* b2 = last ? nB : cB + (size_t)(t + 2) * kstep;
            const char* a3 = a2 + kstep; const char* b3 = b2 + kstep;
            if (last && has_next) S.a_ready(nxt);
            if constexpr (SP2) {
            PG8_LDB(B0, 0, 0); PG8_LDB(B1, 0, 1); PG8_SCHED; PG8_LDA(At, 0, 0); PG8_STAGE(PG8_SA(1, 1), a1 + hstepA, voffA);
            PG8_WAIT_V(8); PG8_WAIT_L(0); PG8_BAR; PG8_MMA(0, 0, At, B0); PG8_MMA(0, 1, At, B1); PG8_BAR; PG8_SCHED;
            PG8_LDA(At, 0, 1); PG8_STAGE(PG8_SB(0, 0), b2, voffB); PG8_STAGE(PG8_SB(0, 1), b2 + hstepB, voffB); PG8_STAGE(PG8_SA(0, 0), a2, voffA);
            PG8_WAIT_V(8); PG8_WAIT_L(0); PG8_BAR; PG8_MMA(1, 0, At, B0); PG8_MMA(1, 1, At, B1); PG8_BAR; PG8_SCHED;
            PG8_LDB(B0, 1, 0); PG8_LDB(B1, 1, 1); PG8_SCHED; PG8_LDA(At, 1, 0); PG8_STAGE(PG8_SA(0, 1), a2 + hstepA, voffA);
            PG8_WAIT_V(8); PG8_WAIT_L(0); PG8_BAR; PG8_MMA(0, 0, At, B0); PG8_MMA(0, 1, At, B1); PG8_BAR; PG8_SCHED;
            PG8_LDA(At, 1, 1); PG8_STAGE(PG8_SB(1, 0), b3, voffB); PG8_STAGE(PG8_SB(1, 1), b3 + hstepB, voffB); PG8_STAGE(PG8_SA(1, 0), a3, voffA);
            PG8_WAIT_V(8); PG8_WAIT_L(0); PG8_BAR; PG8_MMA(1, 0, At, B0); PG8_MMA(1, 1, At, B1); PG8_BAR; PG8_SCHED;
            } else {
            PG8_LDB(B0, 0, 0); PG8_SCHED; PG8_LDA(At, 0, 0); PG8_STAGE(PG8_SA(1, 1), a1 + hstepA, voffA);
            PG8_WAIT_L(8); PG8_BAR; PG8_WAIT_L(0); PG8_MMA(0, 0, At, B0); PG8_BAR; PG8_SCHED;
            PG8_LDB(B1, 0, 1); PG8_STAGE(PG8_SB(0, 0), b2, voffB);
            PG8_BAR; PG8_WAIT_L(0); PG8_MMA(0, 1, At, B1); PG8_BAR;
            PG8_LDA(At, 0, 1); PG8_STAGE(PG8_SA(0, 0), a2, voffA);
            PG8_BAR; PG8_WAIT_L(0); PG8_MMA(1, 0, At, B0); PG8_BAR; PG8_SCHED;
            PG8_STAGE(PG8_SB(0, 1), b2 + hstepB, voffB);
            PG8_WAIT_V(6); PG8_BAR; PG8_MMA(1, 1, At, B1); PG8_BAR;
            PG8_LDB(B0, 1, 0); PG8_SCHED; PG8_LDA(At, 1, 0); PG8_STAGE(PG8_SA(0, 1), a2 + hstepA, voffA);
            PG8_WAIT_L(8); PG8_BAR; PG8_WAIT_L(0); PG8_MMA(0, 0, At, B0); PG8_BAR; PG8_SCHED;
            PG8_LDB(B1, 1, 1); PG8_STAGE(PG8_SB(1, 0), b3, voffB);
            PG8_BAR; PG8_WAIT_L(0); PG8_MMA(0, 1, At, B1); PG8_BAR;
            PG8_LDA(At, 1, 1); PG8_STAGE(PG8_SA(1, 0), a3, voffA);
            PG8_BAR; PG8_WAIT_L(0); PG8_MMA(1, 0, At, B0); PG8_BAR; PG8_SCHED;
            PG8_STAGE(PG8_SB(1, 1), b3 + hstepB, voffB);
            PG8_WAIT_V(6); PG8_BAR; PG8_MMA(1, 1, At, B1); PG8_BAR;
            }
        }
        if constexpr (ALIGN_EPI) { if (wr == 0) PG8_BAR; }
        if constexpr (!Epi::AFTER_DRAIN) { E(acc, cur, wr, wc, fr, fq); S.done(cur); }
        if (!has_next) break;
#pragma unroll
        for (int a = 0; a < 2; ++a)
#pragma unroll
            for (int b = 0; b < 2; ++b)
#pragma unroll
                for (int m = 0; m < 4; ++m)
#pragma unroll
                    for (int n = 0; n < 2; ++n) acc[a][b][m][n] = (f32x4){0.f, 0.f, 0.f, 0.f};
        cur = nxt; cA = nA; cB = nB; ++ui;
        if constexpr (ALIGN_EPI) { if (wr == 1) PG8_BAR; }
    }
    PG8_WAIT_V(0);
    if constexpr (!ALIGN_EPI) { if (wr == 0) PG8_BAR; }
    PG8_BAR;
    if constexpr (Epi::AFTER_DRAIN) { E.fused(acc, cur, wr, wc, fr, fq, lds, wid, lane); S.done(cur); }
#undef PG8_SA
#undef PG8_SB
#undef PG8_STAGE
#undef PG8_LDA
#undef PG8_LDB
#undef PG8_MMA
#undef PG8_WAIT_V
#undef PG8_WAIT_L
#undef PG8_BAR
#undef PG8_SCHED
}
}

#define LAS __attribute__((address_space(3)))
typedef unsigned short bf16_t;
typedef float f32x4 __attribute__((ext_vector_type(4)));
constexpr int D = 1024, NB = 8, SEQ = 2048, CTXL = 256, FF = 4096, HD = 64;
constexpr int ML = NB * SEQ, MC = NB * CTXL, MT = ML + MC;
constexpr int NPE = 2816, NPO = 2304, AIN = 1920;
constexpr int NWAVES = 8, NTHR = 512;
constexpr int LDS_BYTES = 147456;
constexpr float NORM_EPS = 1e-6f, GN_EPS = 64e-5f, LOG2E = 1.4426950408889634f;
constexpr size_t MiB = 1u << 20;
constexpr size_t WS_MOD = 1 * MiB, WS_ROPE = 2 * MiB, WS_W = 3 * MiB, WS_HCTX = 29 * MiB, WS_UMIX = 37 * MiB, WS_A = 73 * MiB, WS_B = 172 * MiB,
                 WS_QKVB = 316 * MiB, WS_END = 343 * MiB;
constexpr size_t W_IN = 0, W_OUT = 6 * MiB, W_1 = 8 * MiB, W_2 = 16 * MiB, W_L = 24 * MiB;
constexpr size_t TOK512 = (size_t)MT * 512;
constexpr size_t B_Y0 = 72 * MiB, B_Y1 = 108 * MiB; constexpr int NLR = 2560;
constexpr size_t WS_O2 = 217 * MiB;
constexpr int NPH = 38;

enum { I_X = 0, I_C, I_CTX, I_CCTX, I_WADA, I_BADA, I_GPREMIX, I_GPOSTMIX, I_GPREFF, I_GPOSTFF, I_WINE, I_WINO, I_WOUT, I_WFF1, I_WFF2,
       I_MUP, I_MUN, I_W0, I_W2, I_A0, I_A2, I_G2, I_KK, I_KA, I_RK, I_GNW, I_GNB, I_SINK, I_RPB, I_QG, I_KG, N_IN };

struct Args { const float* in[N_IN]; float* out; unsigned char* ws; int ph_lo, ph_hi; };
struct AV { const Args& k; int z; int wv;
    __device__ __forceinline__ const float* in(int i) const { return k.in[i + z]; }
    __device__ __forceinline__ unsigned char* ws() const { return k.ws + z; }
    __device__ __forceinline__ float* out() const { return k.out + z; } };

__device__ __forceinline__ unsigned f2bf(float f) { unsigned u = __float_as_uint(f); return (u + 0x7fffu + ((u >> 16) & 1u)) >> 16; }
__device__ __forceinline__ unsigned pk2(float lo, float hi) { return f2bf(lo) | (f2bf(hi) << 16); }
__device__ __forceinline__ float bflo(unsigned u) { return __uint_as_float(u << 16); }
__device__ __forceinline__ float bfhi(unsigned u) { return __uint_as_float(u & 0xffff0000u); }
__device__ __forceinline__ float bf1(bf16_t h) { return __uint_as_float(((unsigned)h) << 16); }
__device__ __forceinline__ void unpack8(const uint4 u, float (&f)[8]) { f[0] = bflo(u.x); f[1] = bfhi(u.x); f[2] = bflo(u.y); f[3] = bfhi(u.y); f[4] = bflo(u.z); f[5] = bfhi(u.z); f[6] = bflo(u.w); f[7] = bfhi(u.w); }
__device__ __forceinline__ uint4 pack8(const float (&f)[8]) { uint4 u; u.x = pk2(f[0], f[1]); u.y = pk2(f[2], f[3]); u.z = pk2(f[4], f[5]); u.w = pk2(f[6], f[7]); return u; }
__device__ __forceinline__ void ld8f(const float* p, float (&f)[8]) { const float4 a = *(const float4*)p, b = *(const float4*)(p + 4); f[0] = a.x; f[1] = a.y; f[2] = a.z; f[3] = a.w; f[4] = b.x; f[5] = b.y; f[6] = b.z; f[7] = b.w; }
__device__ __forceinline__ int otid(const AV& a) { int l; asm volatile("v_mbcnt_lo_u32_b32 %0, -1, 0\n\tv_mbcnt_hi_u32_b32 %0, -1, %0" : "=v"(l)); return a.wv * 64 + l; }
__device__ __forceinline__ int obid() { int b = blockIdx.x; asm volatile("" : "+s"(b)); return b; }
__device__ __forceinline__ float wave_sum(float v) {
#pragma unroll
    for (int o = 1; o < 64; o <<= 1) v += __shfl_xor(v, o);
    return v;
}
__device__ __forceinline__ float wave_max(float v) {
#pragma unroll
    for (int o = 1; o < 64; o <<= 1) v = fmaxf(v, __shfl_xor(v, o));
    return v;
}
__device__ __forceinline__ float sum8(float v) { v += __shfl_xor(v, 1); v += __shfl_xor(v, 2); v += __shfl_xor(v, 4); return v; }
__device__ __forceinline__ float sigmoidf_(float x) { return 1.f / (1.f + __expf(-x)); }

__device__ __forceinline__ void mod_phase(const AV& a, LAS unsigned char* lds) {
    const int tid = otid(a), lane = tid & 63, wave = tid >> 6;
    LAS float* sl = (LAS float*)lds;
    LAS float* red = (LAS float*)(lds + 36864);
    for (int i = tid; i < 9 * 1024; i += NTHR) { const float v = (i < 8192) ? a.in(I_C)[i] : a.in(I_CCTX)[i - 8192]; sl[i] = v / (1.f + __expf(-v)); }
    __syncthreads();
    float* MOD = (float*)(a.ws() + WS_MOD);
    for (int it = obid(); it < 4 * 96; it += gridDim.x) {
        const int layer = it / 96, cgp = it % 96;
        const float* W = a.in(I_WADA) + (size_t)layer * 1024 * 6144 + cgp * 64 + lane;
        float acc[9];
#pragma unroll
        for (int r = 0; r < 9; ++r) acc[r] = 0.f;
        const int k0 = wave * 128;
#pragma unroll 8
        for (int k = 0; k < 128; ++k) {
            const float w = W[(size_t)(k0 + k) * 6144];
#pragma unroll
            for (int r = 0; r < 9; ++r) acc[r] += sl[r * 1024 + k0 + k] * w;
        }
#pragma unroll
        for (int r = 0; r < 9; ++r) red[(wave * 9 + r) * 64 + lane] = acc[r];
        __syncthreads();
        for (int o = tid; o < 576; o += NTHR) {
            const int r = o >> 6, cl = o & 63; float s = 0.f;
#pragma unroll
            for (int w = 0; w < 8; ++w) s += red[(w * 9 + r) * 64 + cl];
            const int col = cgp * 64 + cl;
            MOD[(size_t)(layer * 9 + r) * 6144 + col] = s + a.in(I_BADA)[layer * 6144 + col];
        }
        __syncthreads();
    }
}
__device__ __forceinline__ void rope_phase(const AV& a) {
    float2* R = (float2*)(a.ws() + WS_ROPE);
    for (int i = obid() * NTHR + otid(a); i < SEQ * 32; i += gridDim.x * NTHR) {
        const int t = i >> 5, f = i & 31; const float pos = (float)((f < 16) ? (t >> 6) : (t & 63));
        const float inv = exp2f(-(float)(f & 15) * 0.8304820237218406f);
        const float ang = pos * inv; const float k = rintf(ang * 0.15915494309189535f);
        float r = fmaf(-k, 6.28125f, ang); r = fmaf(-k, 0.0019353071795864769f, r);
        R[i] = make_float2(cosf(r), sinf(r));
    }
}

__device__ __forceinline__ void transpose_item(const float* W, int K, int N, bf16_t* WT, LAS float* scr, int item, int lane) {
    const int nblk = N / 32, kb = item / nblk, nb = item % nblk, k0 = 64 * kb, n0 = 32 * nb;
#pragma unroll 8
    for (int i = 0; i < 32; ++i) { const int kk = 2 * i + (lane >> 5); scr[kk * 33 + (lane & 31)] = W[(size_t)(k0 + kk) * N + n0 + (lane & 31)]; }
    asm volatile("s_waitcnt lgkmcnt(0)" ::: "memory");
    const int c = lane & 7;
#pragma unroll
    for (int j = 0; j < 4; ++j) { const int n = (lane >> 3) + 8 * j; const LAS float* s = scr + (8 * c) * 33 + n;
        uint4 o; o.x = pk2(s[0 * 33], s[1 * 33]); o.y = pk2(s[2 * 33], s[3 * 33]); o.z = pk2(s[4 * 33], s[5 * 33]); o.w = pk2(s[6 * 33], s[7 * 33]);
        *(uint4*)(WT + (size_t)(n0 + n) * K + k0 + 8 * c) = o; }
    asm volatile("s_waitcnt lgkmcnt(0)" ::: "memory");
}
__device__ __forceinline__ void wconv_phase(const AV& a, LAS unsigned char* lds, int layer) {
    const int tid = otid(a), lane = tid & 63, wave = tid >> 6;
    LAS float* scr = (LAS float*)(lds + 65536 + wave * 8704);
    const int gw = obid() * NWAVES + wave, NGW = gridDim.x * NWAVES;
    const bool even = (layer & 1) == 0; const int j = layer >> 1;
    const int NIN = even ? 2688 : 2304;
    const float* Win = even ? a.in(I_WINE) + (size_t)j * D * 2688 : a.in(I_WINO) + (size_t)j * D * 2304;
    bf16_t* WinT = (bf16_t*)(a.ws() + WS_W + W_IN); bf16_t* WoT = (bf16_t*)(a.ws() + WS_W + W_OUT); bf16_t* W1T = (bf16_t*)(a.ws() + WS_W + W_1); bf16_t* W2T = (bf16_t*)(a.ws() + WS_W + W_2);
    const int I_in = (D / 64) * (NIN / 32), I_o = (D / 64) * (D / 32), I_1 = (D / 64) * (FF / 32), I_2 = (FF / 64) * (D / 32);
    const int NIT = I_in + I_o + I_1 + I_2;
    for (int it = gw; it < NIT; it += NGW) {
        int r = it;
        if (r < I_in) { transpose_item(Win, D, NIN, WinT, scr, r, lane); continue; } r -= I_in;
        if (r < I_o) { transpose_item(a.in(I_WOUT) + (size_t)layer * D * D, D, D, WoT, scr, r, lane); continue; } r -= I_o;
        if (r < I_1) { transpose_item(a.in(I_WFF1) + (size_t)layer * D * FF, D, FF, W1T, scr, r, lane); continue; } r -= I_1;
        transpose_item(a.in(I_WFF2) + (size_t)layer * FF * D, FF, D, W2T, scr, r, lane);
    }
    if (even) {
        uint4* z = (uint4*)(WinT + (size_t)2688 * D);
        for (int i = obid() * NTHR + tid; i < 128 * D / 8; i += gridDim.x * NTHR) z[i] = make_uint4(0, 0, 0, 0);
        bf16_t* LT = (bf16_t*)(a.ws() + WS_W + W_L);
        const float* w2 = a.in(I_W2) + (size_t)j * 2 * 64 * 512; const float* a2 = a.in(I_A2) + (size_t)j * 2 * 64 * 512; const float* g2 = a.in(I_G2) + (size_t)j * 128 * 512;
        for (int i = obid() * NTHR + tid; i < 2560 * 384; i += gridDim.x * NTHR) {
            const int n = i / 384, k = i % 384; const int arr = n >> 9, ch = n & 511; float v = 0.f;
            if (arr < 2) { if ((k >> 6) == arr) v = w2[((size_t)arr * 64 + (k & 63)) * 512 + ch]; }
            else if (arr < 4) { if ((k >> 6) == arr) v = a2[((size_t)(arr - 2) * 64 + (k & 63)) * 512 + ch]; }
            else { if (k >= 256) v = g2[(size_t)(k - 256) * 512 + ch]; }
            LT[i] = (bf16_t)f2bf(v);
        }
    }
}

struct NormJob {
    int rows;
    const float* o_src;
    const float* gate; const float* gpost;
    bool h_in_input; bool write_h;
    const float* shift; const float* scale; const float* gpre;
};
__device__ __forceinline__ void norm_phase(const AV& a, const NormJob& jb) {
    const int tid = otid(a), lane = tid & 63, wave = tid >> 6;
    const int gw = obid() * NWAVES + wave, NGW = gridDim.x * NWAVES;
    float* hctx = (float*)(a.ws() + WS_HCTX); bf16_t* U = (bf16_t*)(a.ws() + WS_UMIX);
    for (int m = gw; m < jb.rows; m += NGW) {
        const int mb = (m < ML) ? (m >> 11) : 8;
        const float* hin = jb.h_in_input ? ((m < ML) ? a.in(I_X) + (size_t)m * D : a.in(I_CTX) + (size_t)(m - ML) * D)
                                         : ((m < ML) ? a.out() + (size_t)m * D : hctx + (size_t)(m - ML) * D);
        float* hout = (m < ML) ? a.out() + (size_t)m * D : hctx + (size_t)(m - ML) * D;
        f32x4 h[4];
#pragma unroll
        for (int q = 0; q < 4; ++q) h[q] = *(const f32x4*)(hin + 4 * lane + 256 * q);
        if (jb.o_src) {
            f32x4 o[4]; float ss = 0.f;
#pragma unroll
            for (int q = 0; q < 4; ++q) { o[q] = *(const f32x4*)(jb.o_src + (size_t)m * D + 4 * lane + 256 * q); ss += (o[q][0] * o[q][0] + o[q][1] * o[q][1]) + (o[q][2] * o[q][2] + o[q][3] * o[q][3]); }
            const float rms = rsqrtf(wave_sum(ss) * (1.f / D) + NORM_EPS);
#pragma unroll
            for (int q = 0; q < 4; ++q) {
                const f32x4 g = *(const f32x4*)(jb.gate + (size_t)mb * 6144 + 4 * lane + 256 * q), gp = *(const f32x4*)(jb.gpost + 4 * lane + 256 * q);
                h[q] = h[q] + g * (o[q] * rms * gp);
            }
        }
        if (jb.write_h) {
#pragma unroll
            for (int q = 0; q < 4; ++q) *(f32x4*)(hout + 4 * lane + 256 * q) = h[q];
        }
        if (jb.gpre) {
            float ss = 0.f;
#pragma unroll
            for (int q = 0; q < 4; ++q) ss += (h[q][0] * h[q][0] + h[q][1] * h[q][1]) + (h[q][2] * h[q][2] + h[q][3] * h[q][3]);
            const float rms = rsqrtf(wave_sum(ss) * (1.f / D) + NORM_EPS);
#pragma unroll
            for (int q = 0; q < 4; ++q) {
                const int col = 4 * lane + 256 * q;
                const f32x4 gp = *(const f32x4*)(jb.gpre + col), sc = *(const f32x4*)(jb.scale + (size_t)mb * 6144 + col), sh = *(const f32x4*)(jb.shift + (size_t)mb * 6144 + col);
                const f32x4 u = (h[q] * rms * gp) * (sc + 1.f) + sh;
                uint2 w; w.x = pk2(u[0], u[1]); w.y = pk2(u[2], u[3]);
                *(uint2*)(U + (size_t)m * D + col) = w;
            }
        }
    }
}

__device__ __forceinline__ void prep1_phase(const AV& a, int j) {
    const int tid = otid(a), lane = tid & 63, wave = tid >> 6;
    const int gw = obid() * NWAVES + wave, NGW = gridDim.x * NWAVES;
    const bf16_t* P = (const bf16_t*)(a.ws() + WS_A);
    bf16_t* RB = (bf16_t*)(a.ws() + WS_B); bf16_t* KB = RB + TOK512; bf16_t* VB = RB + 2 * TOK512; bf16_t* KKB = RB + 3 * TOK512;
    bf16_t* LA = (bf16_t*)(a.ws() + WS_UMIX);
    bf16_t* QKVB = (bf16_t*)(a.ws() + WS_QKVB);
    const float2* ROPE = (const float2*)(a.ws() + WS_ROPE);
    const float* mup = a.in(I_MUP) + j * AIN; const float* mun = a.in(I_MUN) + j * AIN; const float* k_k = a.in(I_KK) + j * 512;
    for (int m = gw; m < MT; m += NGW) {
        int t, len; if (m < ML) { t = m & (SEQ - 1); len = SEQ; } else { t = (m - ML) & (CTXL - 1); len = CTXL; }
        const bool hasp = t > 0, hasn = t < len - 1;
        const bf16_t* row = P + (size_t)m * NPE;
#pragma unroll
        for (int ps = 0; ps < 4; ++ps) {
            const int col = ps * 512 + lane * 8;
            const bool act = (ps < 3) || (lane < 48);
            float x[8];
            if (act) {
                float c[8], p[8], n[8], mp[8], mn[8];
                unpack8(*(const uint4*)(row + col), c);
                if (hasp) unpack8(*(const uint4*)(row - NPE + col), p); else {
#pragma unroll
                    for (int e = 0; e < 8; ++e) p[e] = 0.f; }
                if (hasn) unpack8(*(const uint4*)(row + NPE + col), n); else {
#pragma unroll
                    for (int e = 0; e < 8; ++e) n[e] = 0.f; }
                ld8f(mup + col, mp); ld8f(mun + col, mn);
#pragma unroll
                for (int e = 0; e < 8; ++e) x[e] = c[e] + mp[e] * (p[e] - c[e]) + mn[e] * (n[e] - c[e]);
            } else {
#pragma unroll
                for (int e = 0; e < 8; ++e) x[e] = 0.f;
            }
            if (ps == 0) *(uint4*)(RB + (size_t)m * 512 + lane * 8) = pack8(x);
            if (ps == 1) {
                *(uint4*)(KB + (size_t)m * 512 + lane * 8) = pack8(x);
                float kkv[8], kw[8]; ld8f(k_k + lane * 8, kw); float ss = 0.f;
#pragma unroll
                for (int e = 0; e < 8; ++e) { kkv[e] = x[e] * kw[e]; ss += kkv[e] * kkv[e]; }
                ss = sum8(ss);
                const float inv = 1.f / fmaxf(sqrtf(ss), 1e-12f);
#pragma unroll
                for (int e = 0; e < 8; ++e) kkv[e] *= inv;
                *(uint4*)(KKB + (size_t)m * 512 + lane * 8) = pack8(kkv);
            }
            if (ps == 2) *(uint4*)(VB + (size_t)m * 512 + lane * 8) = pack8(x);
            if (ps == 3 && act) {
                float y[8];
#pragma unroll
                for (int e = 0; e < 8; ++e) {
                    if (lane < 16) { const float ex = __expf(2.f * x[e]); y[e] = 1.f - 2.f / (ex + 1.f); }
                    else if (lane < 32) y[e] = x[e];
                    else y[e] = sigmoidf_(x[e]);
                }
                *(uint4*)(LA + (size_t)m * 1024 + lane * 8) = pack8(y);
            }
        }
#pragma unroll
        for (int ps = 0; ps < 2; ++ps) {
            const bool act = (ps == 0) || (lane < 32);
            const int col = (ps == 0 ? 1920 : 2432) + lane * 8;
            float x[8];
            if (act) unpack8(*(const uint4*)(row + col), x); else {
#pragma unroll
                for (int e = 0; e < 8; ++e) x[e] = 0.f; }
            float xp[8];
#pragma unroll
            for (int e = 0; e < 8; ++e) xp[e] = __shfl_xor(x[e], 2);
            const bool roped = (m < ML) && (ps == 0 || lane < 16);
            if (roped) {
                const int c8 = lane & 7; const float2* tab = ROPE + (size_t)t * 32 + 16 * (c8 >> 2) + 8 * (c8 & 1);
#pragma unroll
                for (int e = 0; e < 8; ++e) { const float2 cs = tab[e]; x[e] = (c8 & 2) ? (xp[e] * cs.y + x[e] * cs.x) : (x[e] * cs.x - xp[e] * cs.y); }
            }
            if (act) *(uint4*)(QKVB + (size_t)m * 768 + (ps == 0 ? 0 : 512) + lane * 8) = pack8(x);
        }
    }
}

__device__ __forceinline__ void qknorm_phase(const AV& a, int j) {
    const int tid = otid(a), lane = tid & 63, wave = tid >> 6;
    const int gw = obid() * NWAVES + wave, NGW = gridDim.x * NWAVES;
    bf16_t* P = (bf16_t*)(a.ws() + WS_A);
    const float2* ROPE = (const float2*)(a.ws() + WS_ROPE);
    const float* qg = a.in(I_QG) + j * 64; const float* kg = a.in(I_KG) + j * 64;
    for (int m = gw; m < MT; m += NGW) {
        const int t = m & (SEQ - 1);
        bf16_t* row = P + (size_t)m * NPO;
#pragma unroll
        for (int ps = 0; ps < 2; ++ps) {
            const bool act = (ps == 0) || (lane < 16);
            const int col = (ps == 0 ? 1536 : 2048) + lane * 8;
            float x[8];
            if (act) unpack8(*(const uint4*)(row + col), x); else {
#pragma unroll
                for (int e = 0; e < 8; ++e) x[e] = 0.f; }
            float ss = 0.f;
#pragma unroll
            for (int e = 0; e < 8; ++e) ss += x[e] * x[e];
            ss = sum8(ss);
            const float rms = rsqrtf(ss * (1.f / 64.f) + NORM_EPS);
            float g[8]; ld8f((ps == 0 ? qg : kg) + (lane & 7) * 8, g);
#pragma unroll
            for (int e = 0; e < 8; ++e) x[e] = x[e] * rms * g[e];
            float xp[8];
#pragma unroll
            for (int e = 0; e < 8; ++e) xp[e] = __shfl_xor(x[e], 2);
            if (m < ML) {
                const int c8 = lane & 7; const float2* tab = ROPE + (size_t)t * 32 + 16 * (c8 >> 2) + 8 * (c8 & 1);
#pragma unroll
                for (int e = 0; e < 8; ++e) { const float2 cs = tab[e]; x[e] = (c8 & 2) ? (xp[e] * cs.y + x[e] * cs.x) : (x[e] * cs.x - xp[e] * cs.y); }
            }
            if (act) *(uint4*)(row + col) = pack8(x);
        }
    }
}

__device__ __forceinline__ void rwkv_out_phase(const AV& a, int j) {
    const int tid = otid(a), lane = tid & 63, wave = tid >> 6;
    const int gw = obid() * NWAVES + wave, NGW = gridDim.x * NWAVES;
    const float* Y0 = (const float*)(a.ws() + WS_B + B_Y0); const float* Y1 = (const float*)(a.ws() + WS_B + B_Y1);
    const bf16_t* LR = (const bf16_t*)(a.ws() + WS_A);
    const bf16_t* RB = (const bf16_t*)(a.ws() + WS_B); const bf16_t* KB = RB + TOK512; const bf16_t* VB = RB + 2 * TOK512;
    bf16_t* MIX = (bf16_t*)(a.ws() + WS_UMIX);
    const float* k_a = a.in(I_KA) + j * 512; const float* r_k = a.in(I_RK) + j * 512; const float* gnw = a.in(I_GNW) + j * 512; const float* gnb = a.in(I_GNB) + j * 512;
    const int ch = lane * 8;
    float ka[8], rk[8], gw8[8], gb8[8], ab0[8], ab1[8]; ld8f(k_a + ch, ka); ld8f(r_k + ch, rk); ld8f(gnw + ch, gw8); ld8f(gnb + ch, gb8);
    ld8f(a.in(I_A0) + j * 1024 + ch, ab0); ld8f(a.in(I_A0) + j * 1024 + 512 + ch, ab1);
    for (int m = gw; m < MT; m += NGW) {
        const size_t o = (size_t)m * 512 + ch;
        float y[8], y1[8]; ld8f(Y0 + o, y); ld8f(Y1 + o, y1);
        float s = 0.f;
#pragma unroll
        for (int e = 0; e < 8; ++e) { y[e] += y1[e]; s += y[e]; }
        const float mu = sum8(s) * (1.f / 64.f); float q = 0.f;
#pragma unroll
        for (int e = 0; e < 8; ++e) { y[e] -= mu; q += y[e] * y[e]; }
        const float rstd = rsqrtf(sum8(q) * (1.f / 64.f) + GN_EPS);
        float r[8], k[8], v[8], a0[8], a1[8], g[8];
        unpack8(*(const uint4*)(RB + o), r); unpack8(*(const uint4*)(KB + o), k); unpack8(*(const uint4*)(VB + o), v);
        const bf16_t* lr = LR + (size_t)m * NLR + ch;
        unpack8(*(const uint4*)(lr + 1024), a0); unpack8(*(const uint4*)(lr + 1536), a1); unpack8(*(const uint4*)(lr + 2048), g);
#pragma unroll
        for (int e = 0; e < 8; ++e) { a0[e] = sigmoidf_(a0[e] + ab0[e]); a1[e] = sigmoidf_(a1[e] + ab1[e]); }
        float bs = 0.f;
#pragma unroll
        for (int e = 0; e < 8; ++e) { const float kd = k[e] * (1.f + (a0[e] - 1.f) * ka[e]) + k[e] * (1.f + (a1[e] - 1.f) * ka[e]); bs += r[e] * kd * rk[e]; }
        bs = sum8(bs);
        float outv[8];
#pragma unroll
        for (int e = 0; e < 8; ++e) outv[e] = (y[e] * rstd * gw8[e] + gb8[e] + bs * v[e]) * g[e];
        *(uint4*)(MIX + (size_t)m * 1024 + ch) = pack8(outv);
    }
}

__device__ __forceinline__ void scan_naive_phase(const AV& a, int j) {
    const int tid = otid(a), lane = tid & 63, wave = tid >> 6;
    const int gw = obid() * NWAVES + wave, NGW = gridDim.x * NWAVES;
    const bf16_t* RB = (const bf16_t*)(a.ws() + WS_B); const bf16_t* KB = RB + TOK512; const bf16_t* VB = RB + 2 * TOK512; const bf16_t* KKB = RB + 3 * TOK512;
    for (int cq = gw; cq < 512; cq += NGW) {
        const int cb = cq >> 2, rq = cq & 3;
        const int dir = cb & 1, h = (cb >> 1) & 7, b = cb >> 4;
        const int row = rq * 16 + (lane >> 2), part = lane & 3;
        const bf16_t* LR = (const bf16_t*)(a.ws() + WS_A) + dir * 512 + h * 64 + part * 16;
        float* Y = (float*)(a.ws() + WS_B + (dir ? B_Y1 : B_Y0));
        float w0[16], a0[16];
        ld8f(a.in(I_W0) + j * 1024 + dir * 512 + h * 64 + part * 16, *(float(*)[8])&w0[0]); ld8f(a.in(I_W0) + j * 1024 + dir * 512 + h * 64 + part * 16 + 8, *(float(*)[8])&w0[8]);
        ld8f(a.in(I_A0) + j * 1024 + dir * 512 + h * 64 + part * 16, *(float(*)[8])&a0[0]); ld8f(a.in(I_A0) + j * 1024 + dir * 512 + h * 64 + part * 16 + 8, *(float(*)[8])&a0[8]);
        float ka[16]; ld8f(a.in(I_KA) + j * 512 + h * 64 + part * 16, *(float(*)[8])&ka[0]); ld8f(a.in(I_KA) + j * 512 + h * 64 + part * 16 + 8, *(float(*)[8])&ka[8]);
        float S[16];
#pragma unroll
        for (int k = 0; k < 16; ++k) S[k] = 0.f;
        for (int s = 0; s < CTXL + SEQ; ++s) {
            int m;
            if (s < CTXL) m = ML + b * CTXL + (dir ? (CTXL - 1 - s) : s);
            else m = b * SEQ + (dir ? (SEQ - 1 - (s - CTXL)) : (s - CTXL));
            const size_t oh = (size_t)m * 512 + h * 64, o = oh + part * 16;
            const float vv = bf1(VB[oh + row]);
            float kk[16], ee[16], ai[16], kx[16], rr[16];
            unpack8(*(const uint4*)(KKB + o), *(float(*)[8])&kk[0]); unpack8(*(const uint4*)(KKB + o + 8), *(float(*)[8])&kk[8]);
            const bf16_t* lr = LR + (size_t)m * NLR;
            unpack8(*(const uint4*)(lr), *(float(*)[8])&ee[0]);  unpack8(*(const uint4*)(lr + 8), *(float(*)[8])&ee[8]);
            unpack8(*(const uint4*)(lr + 1024), *(float(*)[8])&ai[0]);  unpack8(*(const uint4*)(lr + 1032), *(float(*)[8])&ai[8]);
#pragma unroll
            for (int k = 0; k < 16; ++k) { ee[k] = 0.60653065971263342f * sigmoidf_(ee[k] + w0[k]); ai[k] = sigmoidf_(ai[k] + a0[k]); }
            unpack8(*(const uint4*)(KB + o), *(float(*)[8])&kx[0]);  unpack8(*(const uint4*)(KB + o + 8), *(float(*)[8])&kx[8]);
            unpack8(*(const uint4*)(RB + o), *(float(*)[8])&rr[0]);  unpack8(*(const uint4*)(RB + o + 8), *(float(*)[8])&rr[8]);
            float d = 0.f;
#pragma unroll
            for (int k = 0; k < 16; ++k) d += S[k] * kk[k];
            d += __shfl_xor(d, 1); d += __shfl_xor(d, 2);
            const float sa = -d;
            float y = 0.f;
#pragma unroll
            for (int k = 0; k < 16; ++k) {
                const float w = __expf(-ee[k]), bb = kk[k] * ai[k], kd = kx[k] * (1.f + (ai[k] - 1.f) * ka[k]);
                const float sn = S[k] * w + sa * bb + vv * kd;
                S[k] = sn; y += sn * rr[k];
            }
            y += __shfl_xor(y, 1); y += __shfl_xor(y, 2);
            if (part == 0) Y[oh + row] = y;
        }
    }
}

template <class KF> __device__ __forceinline__ void attn_naive_row(const bf16_t* qp, const KF& kf, int nkeys, bool has_sink, float sink, bf16_t* outp, int lane) {
    float q[64];
#pragma unroll
    for (int c = 0; c < 8; ++c) { float t8[8]; unpack8(*(const uint4*)(qp + c * 8), t8);
#pragma unroll
        for (int e = 0; e < 8; ++e) q[c * 8 + e] = t8[e]; }
    float mrun = -1e30f, lrun = 0.f; float o[64];
#pragma unroll
    for (int d = 0; d < 64; ++d) o[d] = 0.f;
    for (int j = lane; j < nkeys; j += 64) {
        const bf16_t* kp; const bf16_t* vp; float bias;
        if (!kf(j, kp, vp, bias)) continue;
        float s = 0.f;
#pragma unroll
        for (int c = 0; c < 8; ++c) { float t8[8]; unpack8(*(const uint4*)(kp + c * 8), t8);
#pragma unroll
            for (int e = 0; e < 8; ++e) s += q[c * 8 + e] * t8[e]; }
        s = s * 0.125f + bias;
        const float mn = fmaxf(mrun, s), al = __expf(mrun - mn), p = __expf(s - mn);
        lrun = lrun * al + p; mrun = mn;
#pragma unroll
        for (int c = 0; c < 8; ++c) { float t8[8]; unpack8(*(const uint4*)(vp + c * 8), t8);
#pragma unroll
            for (int e = 0; e < 8; ++e) o[c * 8 + e] = o[c * 8 + e] * al + p * t8[e]; }
    }
    float M = wave_max(mrun); if (has_sink) M = fmaxf(M, sink);
    const float sc = __expf(mrun - M);
    const float L = wave_sum(lrun * sc) + (has_sink ? __expf(sink - M) : 0.f);
    float res = 0.f;
#pragma unroll
    for (int d = 0; d < 64; ++d) { const float v = wave_sum(o[d] * sc); if (lane == d) res = v; }
    outp[lane] = (bf16_t)f2bf(res / L);
}

struct KfB {
    const bf16_t* QKVB; int b, t, kvh; bool ctxq;
    __device__ __forceinline__ bool operator()(int j, const bf16_t*& kp, const bf16_t*& vp, float& bias) const {
        bias = 0.f; size_t row;
        if (ctxq) row = (size_t)ML + b * CTXL + j;
        else if (j < 257) { const int kpos = t - 128 + j; if (kpos < 0 || kpos >= SEQ) return false; row = (size_t)b * SEQ + kpos; }
        else row = (size_t)ML + b * CTXL + (j - 257);
        kp = QKVB + row * 768 + 512 + kvh * 64; vp = kp + 128; return true;
    }
};
struct KfC {
    const bf16_t* P; const float* rpb; int b, r, c, h; bool ctxq;
    __device__ __forceinline__ bool operator()(int j, const bf16_t*& kp, const bf16_t*& vp, float& bias) const {
        size_t row; bias = 0.f;
        if (ctxq) row = (size_t)ML + b * CTXL + j;
        else if (j < 128) {
            const int i = j >> 4, jj = j & 15;
            const int kr = min(max(r - 4, 0), 24) + i, kc = min(max(c - 8, 0), 48) + jj;
            const int dr = kr - r + 7, dc = min(max(kc - c + 15, 0), 30);
            bias = rpb[(h * 15 + dr) * 31 + dc];
            row = (size_t)b * SEQ + kr * 64 + kc;
        } else row = (size_t)ML + b * CTXL + (j - 128);
        kp = P + row * NPO + 512 + h * 64; vp = kp + 512; return true;
    }
};
struct KfD {
    const bf16_t* P; int b, kvh; bool ctxq;
    __device__ __forceinline__ bool operator()(int j, const bf16_t*& kp, const bf16_t*& vp, float& bias) const {
        bias = 0.f; const size_t row = (j < CTXL) ? (size_t)ML + b * CTXL + j : (size_t)b * SEQ + (j - CTXL);
        kp = P + row * NPO + 2048 + kvh * 64; vp = kp + 128; return true;
    }
};

__device__ __forceinline__ void attnB_naive_phase(const AV& a, int j, bool need_ctx) {
    const int tid = otid(a), lane = tid & 63, wave = tid >> 6;
    const int gw = obid() * NWAVES + wave, NGW = gridDim.x * NWAVES;
    const bf16_t* QKVB = (const bf16_t*)(a.ws() + WS_QKVB); bf16_t* MIX = (bf16_t*)(a.ws() + WS_UMIX);
    const int rows = need_ctx ? MT : ML;
    for (int it = gw; it < rows * 8; it += NGW) {
        const int m = it >> 3, hq = it & 7;
        KfB kf; kf.QKVB = QKVB; kf.kvh = hq >> 2; kf.ctxq = m >= ML;
        if (m < ML) { kf.b = m >> 11; kf.t = m & (SEQ - 1); } else { kf.b = (m - ML) >> 8; kf.t = 0; }
        attn_naive_row(QKVB + (size_t)m * 768 + hq * 64, kf, kf.ctxq ? CTXL : 257 + CTXL, true, a.in(I_SINK)[j * 8 + hq], MIX + (size_t)m * 1024 + 512 + hq * 64, lane);
    }
}
__device__ __forceinline__ void attnCD_naive_phase(const AV& a, int j, bool need_ctx) {
    const int tid = otid(a), lane = tid & 63, wave = tid >> 6;
    const int gw = obid() * NWAVES + wave, NGW = gridDim.x * NWAVES;
    const bf16_t* P = (const bf16_t*)(a.ws() + WS_A); bf16_t* MIX = (bf16_t*)(a.ws() + WS_UMIX);
    const int rows = need_ctx ? MT : ML;
    for (int it = gw; it < rows * 16; it += NGW) {
        const int m = it >> 4, hh = it & 15;
        const bool ctxq = m >= ML; const int b = ctxq ? (m - ML) >> 8 : m >> 11; const int t = m & (SEQ - 1);
        if (hh < 8) {
            KfC kf; kf.P = P; kf.rpb = a.in(I_RPB) + (size_t)j * 8 * 15 * 31; kf.b = b; kf.r = t >> 6; kf.c = t & 63; kf.h = hh; kf.ctxq = ctxq;
            attn_naive_row(P + (size_t)m * NPO + hh * 64, kf, ctxq ? CTXL : 128 + CTXL, false, 0.f, MIX + (size_t)m * 1024 + hh * 64, lane);
        } else {
            const int hq = hh - 8;
            KfD kf; kf.P = P; kf.b = b; kf.kvh = hq >> 2; kf.ctxq = ctxq;
            attn_naive_row(P + (size_t)m * NPO + 1536 + hq * 64, kf, ctxq ? CTXL : CTXL + SEQ, false, 0.f, MIX + (size_t)m * 1024 + 512 + hq * 64, lane);
        }
    }
}


typedef short bf16x8_t __attribute__((ext_vector_type(8)));
typedef float f32x16_t __attribute__((ext_vector_type(16)));
typedef unsigned u32x4_t __attribute__((ext_vector_type(4)));
typedef unsigned u32x2_t __attribute__((ext_vector_type(2)));
constexpr int AK_PITCH = 144, AV_PITCH = 136, AV_OFF = 64 * AK_PITCH, ABUF = AV_OFF + 64 * AV_PITCH;
constexpr float ATT_SC = 0.125f * LOG2E, NEGBIG = -1e30f;
struct AttnSt { f32x16_t o0, o1; float m2, l; };
struct StageRegs { uint4 a, b; };

__device__ __forceinline__ void attn_load_tile(StageRegs& sr, const bf16_t* base, int pitch, int kcol, int vcol, int tid) {
    if (tid < 256) { const int key = tid >> 3, c = tid & 7; sr.a = *(const uint4*)(base + (size_t)key * pitch + kcol + c * 8); sr.b = *(const uint4*)(base + (size_t)(key + 32) * pitch + kcol + c * 8); }
    else { const int t2 = tid - 256, kp = t2 >> 3, c = t2 & 7; sr.a = *(const uint4*)(base + (size_t)(2 * kp) * pitch + vcol + c * 8); sr.b = *(const uint4*)(base + (size_t)(2 * kp + 1) * pitch + vcol + c * 8); }
}
__device__ __forceinline__ void attn_store_tile(const StageRegs& sr, LAS unsigned char* buf, int tid) {
    if (tid < 256) { const int key = tid >> 3, c = tid & 7; *(LAS u32x4_t*)(buf + key * AK_PITCH + c * 16) = (u32x4_t){sr.a.x, sr.a.y, sr.a.z, sr.a.w}; *(LAS u32x4_t*)(buf + (key + 32) * AK_PITCH + c * 16) = (u32x4_t){sr.b.x, sr.b.y, sr.b.z, sr.b.w}; }
    else {
        const int t2 = tid - 256, kp = t2 >> 3, c = t2 & 7; LAS unsigned char* vt = buf + AV_OFF + (8 * c) * AV_PITCH + kp * 4;
        const unsigned a[4] = {sr.a.x, sr.a.y, sr.a.z, sr.a.w}, b[4] = {sr.b.x, sr.b.y, sr.b.z, sr.b.w};
#pragma unroll
        for (int i = 0; i < 4; ++i) {
            *(LAS unsigned*)(vt + (2 * i) * AV_PITCH) = (a[i] & 0xffffu) | (b[i] << 16);
            *(LAS unsigned*)(vt + (2 * i + 1) * AV_PITCH) = (a[i] >> 16) | (b[i] & 0xffff0000u);
        }
    }
}
template <class SF> __device__ __forceinline__ void attn_subtile(AttnSt& st, const bf16x8_t (&qf)[4], LAS const unsigned char* buf, int koff, int lane, const SF& sf) {
    const int q = lane & 31, h = lane >> 5;
    f32x16_t s;
#pragma unroll
    for (int r = 0; r < 16; ++r) s[r] = 0.f;
    LAS const unsigned char* kp = buf + (koff + q) * AK_PITCH + h * 16;
#pragma unroll
    for (int ds = 0; ds < 4; ++ds) { const bf16x8_t kf = *(LAS const bf16x8_t*)(kp + ds * 32); s = __builtin_amdgcn_mfma_f32_32x32x16_bf16(kf, qf[ds], s, 0, 0, 0); }
    float tm = NEGBIG;
#pragma unroll
    for (int r = 0; r < 16; ++r) { const int key = koff + (r & 3) + 8 * (r >> 2) + 4 * h; s[r] = sf(s[r], key); tm = fmaxf(tm, s[r]); }
    tm = fmaxf(tm, __shfl_xor(tm, 32));
    const float mn = fmaxf(st.m2, tm), alpha = __builtin_amdgcn_exp2f(st.m2 - mn); st.m2 = mn;
    float ps = 0.f;
#pragma unroll
    for (int r = 0; r < 16; ++r) { s[r] = __builtin_amdgcn_exp2f(s[r] - mn); ps += s[r]; }
    st.l = st.l * alpha + ps;
    st.o0 = st.o0 * alpha; st.o1 = st.o1 * alpha;
    bf16x8_t pf[2];
#pragma unroll
    for (int k2 = 0; k2 < 2; ++k2) { uint4 w; w.x = pk2(s[8 * k2 + 0], s[8 * k2 + 1]); w.y = pk2(s[8 * k2 + 2], s[8 * k2 + 3]); w.z = pk2(s[8 * k2 + 4], s[8 * k2 + 5]); w.w = pk2(s[8 * k2 + 6], s[8 * k2 + 7]);
        pf[k2] = __builtin_bit_cast(bf16x8_t, w); }
    LAS const unsigned char* vp = buf + AV_OFF + q * AV_PITCH + (koff + 4 * h) * 2;
#pragma unroll
    for (int k2 = 0; k2 < 2; ++k2) {
        { const u32x2_t lo = *(LAS const u32x2_t*)(vp + k2 * 32), hi = *(LAS const u32x2_t*)(vp + k2 * 32 + 16); const u32x4_t w = {lo.x, lo.y, hi.x, hi.y};
          st.o0 = __builtin_amdgcn_mfma_f32_32x32x16_bf16(__builtin_bit_cast(bf16x8_t, w), pf[k2], st.o0, 0, 0, 0); }
        { const u32x2_t lo = *(LAS const u32x2_t*)(vp + 32 * AV_PITCH + k2 * 32), hi = *(LAS const u32x2_t*)(vp + 32 * AV_PITCH + k2 * 32 + 16); const u32x4_t w = {lo.x, lo.y, hi.x, hi.y};
          st.o1 = __builtin_amdgcn_mfma_f32_32x32x16_bf16(__builtin_bit_cast(bf16x8_t, w), pf[k2], st.o1, 0, 0, 0); }
    }
}
__device__ __forceinline__ void attn_init(AttnSt& st, bf16x8_t (&qf)[4], const bf16_t* qrow, int lane, bool has_sink, float sink) {
    const int h = lane >> 5;
#pragma unroll
    for (int ds = 0; ds < 4; ++ds) qf[ds] = *(const bf16x8_t*)(qrow + 16 * ds + 8 * h);
#pragma unroll
    for (int r = 0; r < 16; ++r) { st.o0[r] = 0.f; st.o1[r] = 0.f; }
    st.m2 = has_sink ? sink * LOG2E : NEGBIG; st.l = (has_sink && h == 0) ? 1.f : 0.f;
}
__device__ __forceinline__ void attn_finish(const AttnSt& st, bf16_t* orow, int lane) {
    const int h = lane >> 5;
    const float lt = st.l + __shfl_xor(st.l, 32), inv = 1.f / lt;
#pragma unroll
    for (int g = 0; g < 4; ++g) {
        uint2 w0, w1;
        w0.x = pk2(st.o0[4 * g] * inv, st.o0[4 * g + 1] * inv); w0.y = pk2(st.o0[4 * g + 2] * inv, st.o0[4 * g + 3] * inv);
        w1.x = pk2(st.o1[4 * g] * inv, st.o1[4 * g + 1] * inv); w1.y = pk2(st.o1[4 * g + 2] * inv, st.o1[4 * g + 3] * inv);
        *(uint2*)(orow + 8 * g + 4 * h) = w0; *(uint2*)(orow + 32 + 8 * g + 4 * h) = w1;
    }
}
struct SfPlain { __device__ __forceinline__ float operator()(float raw, int) const { return raw * ATT_SC; } };
struct SfWin { int rel;
    __device__ __forceinline__ float operator()(float raw, int key) const { const int dd = rel + key; return (dd >= -128 && dd <= 128) ? raw * ATT_SC : NEGBIG; } };
struct SfNat { LAS const float* rpb; int kc0, dr, wlo, qc; bool rowok;
    __device__ __forceinline__ float operator()(float raw, int key) const {
        const int kc = kc0 + key; const bool ok = rowok && kc >= wlo && kc < wlo + 16;
        const int dc = min(max(kc - qc + 15, 0), 30);
        return ok ? raw * ATT_SC + rpb[dr * 31 + dc] : NEGBIG; } };

template <class BaseOf, class Comp> __device__ __forceinline__ void attn_tiles(LAS unsigned char* lds, int NT, int pitch, int kcol, int vcol, int tid, const BaseOf& base_of, const Comp& comp) {
    StageRegs sr;
    attn_load_tile(sr, base_of(0), pitch, kcol, vcol, tid);
    attn_store_tile(sr, lds, tid);
    __syncthreads();
    for (int t = 0; t < NT; ++t) {
        if (t + 1 < NT) attn_load_tile(sr, base_of(t + 1), pitch, kcol, vcol, tid);
        comp(t, (LAS const unsigned char*)(lds + (t & 1) * ABUF));
        if (t + 1 < NT) attn_store_tile(sr, lds + ((t + 1) & 1) * ABUF, tid);
        __syncthreads();
    }
}

__device__ __forceinline__ void attnB_phase(const AV& a, LAS unsigned char* lds, int j, bool need_ctx) {
    const int tid = otid(a), lane = tid & 63, wave = tid >> 6;
    const bf16_t* QKVB = (const bf16_t*)(a.ws() + WS_QKVB); bf16_t* MIX = (bf16_t*)(a.ws() + WS_UMIX);
    const int nitems = 512 + (need_ctx ? 64 : 0);
    for (int it = obid(); it < nitems; it += gridDim.x) {
        const bool ctxq = it >= 512; const int i2 = ctxq ? it - 512 : it;
        const int b = ctxq ? (i2 >> 3) : (i2 >> 6), kvh = ctxq ? ((i2 >> 2) & 1) : ((i2 >> 5) & 1), qc = ctxq ? (i2 & 3) : (i2 & 31);
        const int hq = kvh * 4 + (wave >> 1), tq = qc * 64 + 32 * (wave & 1) + (lane & 31);
        const size_t m = ctxq ? (size_t)ML + b * CTXL + tq : (size_t)b * SEQ + tq;
        AttnSt st; bf16x8_t qf[4];
        attn_init(st, qf, QKVB + m * 768 + hq * 64, lane, true, a.in(I_SINK)[j * 8 + hq]);
        const int tb0 = max(qc - 2, 0), tb1 = min(qc + 2, 31);
        const int NT = ctxq ? 4 : 4 + (tb1 - tb0 + 1);
        const bf16_t* cbase = QKVB + ((size_t)ML + b * CTXL) * 768; const bf16_t* lbase = QKVB + (size_t)b * SEQ * 768;
        attn_tiles(lds, NT, 768, 512 + kvh * 64, 640 + kvh * 64, tid,
            [&](int t) { return t < 4 ? cbase + (size_t)t * 64 * 768 : lbase + (size_t)(tb0 + t - 4) * 64 * 768; },
            [&](int t, LAS const unsigned char* buf) {
                if (t < 4) { attn_subtile(st, qf, buf, 0, lane, SfPlain{}); attn_subtile(st, qf, buf, 32, lane, SfPlain{}); }
                else { const SfWin sf{(tb0 + t - 4) * 64 - tq}; attn_subtile(st, qf, buf, 0, lane, sf); attn_subtile(st, qf, buf, 32, lane, sf); }
            });
        attn_finish(st, MIX + m * 1024 + 512 + hq * 64, lane);
    }
}

__device__ __forceinline__ void attnCD_phase(const AV& a, LAS unsigned char* lds, int j, bool need_ctx) {
    const int tid = otid(a), lane = tid & 63, wave = tid >> 6;
    const bf16_t* P = (const bf16_t*)(a.ws() + WS_A); bf16_t* MIX = (bf16_t*)(a.ws() + WS_UMIX);
    LAS float* rpbs = (LAS float*)(lds + 2 * ABUF);
    const int nitems = 1024 + (need_ctx ? 128 : 0);
    for (int it = obid(); it < nitems; it += gridDim.x) {
        if (it < 512 || (it >= 1024 && it < 1088)) {
            const bool ctxq = it >= 1024; const int i2 = ctxq ? it - 1024 : it;
            const int b = ctxq ? (i2 >> 3) : (i2 >> 6), kvh = ctxq ? ((i2 >> 2) & 1) : ((i2 >> 5) & 1), qc = ctxq ? (i2 & 3) : (i2 & 31);
            const int hq = kvh * 4 + (wave >> 1), tq = qc * 64 + 32 * (wave & 1) + (lane & 31);
            const size_t m = ctxq ? (size_t)ML + b * CTXL + tq : (size_t)b * SEQ + tq;
            AttnSt st; bf16x8_t qf[4];
            attn_init(st, qf, P + m * NPO + 1536 + hq * 64, lane, false, 0.f);
            const int NT = ctxq ? 4 : 36;
            const bf16_t* cbase = P + ((size_t)ML + b * CTXL) * NPO; const bf16_t* lbase = P + (size_t)b * SEQ * NPO;
            attn_tiles(lds, NT, NPO, 2048 + kvh * 64, 2176 + kvh * 64, tid,
                [&](int t) { return t < 4 ? cbase + (size_t)t * 64 * NPO : lbase + (size_t)(t - 4) * 64 * NPO; },
                [&](int t, LAS const unsigned char* buf) { attn_subtile(st, qf, buf, 0, lane, SfPlain{}); attn_subtile(st, qf, buf, 32, lane, SfPlain{}); });
            attn_finish(st, MIX + m * 1024 + 512 + hq * 64, lane);
        } else if (it < 1024) {
            const int i2 = it - 512; const int b = i2 >> 6, h = (i2 >> 3) & 7, r0 = (i2 & 7) * 4;
            const float* rpb = a.in(I_RPB) + ((size_t)j * 8 + h) * 465;
            for (int i = tid; i < 465; i += NTHR) rpbs[i] = rpb[i] * LOG2E;
            const int q = lane & 31, rp = wave >> 2, mb = wave & 3;
            const int qr = r0 + 2 * rp + (q >> 4), qcol = 16 * mb + (q & 15), tq = qr * 64 + qcol;
            const size_t m = (size_t)b * SEQ + tq;
            AttnSt st; bf16x8_t qf[4];
            attn_init(st, qf, P + m * NPO + h * 64, lane, false, 0.f);
            const int krlo = min(max(r0 - 4, 0), 24), krhi = min(max(r0 + 3 - 4, 0), 24) + 7;
            const int NT = 4 + (krhi - krlo + 1);
            const int kc0 = min(max(16 * mb - 8, 0), 32);
            const int wrow = min(max(qr - 4, 0), 24), wlo = min(max(qcol - 8, 0), 48);
            const int ra = r0 + 2 * rp, ulo = min(max(ra - 4, 0), 24), uhi = min(max(ra + 1 - 4, 0), 24) + 7;
            const bf16_t* cbase = P + ((size_t)ML + b * CTXL) * NPO; const bf16_t* lbase = P + (size_t)b * SEQ * NPO;
            attn_tiles(lds, NT, NPO, 512 + h * 64, 1024 + h * 64, tid,
                [&](int t) { return t < 4 ? cbase + (size_t)t * 64 * NPO : lbase + (size_t)(krlo + t - 4) * 64 * NPO; },
                [&](int t, LAS const unsigned char* buf) {
                    if (t < 4) { attn_subtile(st, qf, buf, 0, lane, SfPlain{}); attn_subtile(st, qf, buf, 32, lane, SfPlain{}); }
                    else { const int kr = krlo + t - 4;
                        if (kr >= ulo && kr <= uhi) { const SfNat sf{rpbs, 0, kr - qr + 7, wlo, qcol, kr >= wrow && kr < wrow + 8}; attn_subtile(st, qf, buf, kc0, lane, sf); } }
                });
            attn_finish(st, MIX + m * 1024 + h * 64, lane);
        } else {
            const int i2 = it - 1088; const int b = i2 >> 3, h = i2 & 7;
            const int tq = 32 * wave + (lane & 31);
            const size_t m = (size_t)ML + b * CTXL + tq;
            AttnSt st; bf16x8_t qf[4];
            attn_init(st, qf, P + m * NPO + h * 64, lane, false, 0.f);
            const bf16_t* cbase = P + ((size_t)ML + b * CTXL) * NPO;
            attn_tiles(lds, 4, NPO, 512 + h * 64, 1024 + h * 64, tid,
                [&](int t) { return cbase + (size_t)t * 64 * NPO; },
                [&](int t, LAS const unsigned char* buf) { attn_subtile(st, qf, buf, 0, lane, SfPlain{}); attn_subtile(st, qf, buf, 32, lane, SfPlain{}); });
            attn_finish(st, MIX + m * 1024 + h * 64, lane);
        }
    }
}

constexpr int SC_TS = 32, SC_OPS = SC_TS * 5 * 64 * 4, SC_V = SC_TS * 32 * 4, SC_BUF = SC_OPS + SC_V, SC_YOFF = 2 * SC_BUF;
__device__ __forceinline__ float dpp_sum16(float v) {
    v += __builtin_bit_cast(float, __builtin_amdgcn_update_dpp(0, __builtin_bit_cast(int, v), 0xB1, 0xf, 0xf, true));
    v += __builtin_bit_cast(float, __builtin_amdgcn_update_dpp(0, __builtin_bit_cast(int, v), 0x4E, 0xf, 0xf, true));
    v += __builtin_bit_cast(float, __builtin_amdgcn_update_dpp(0, __builtin_bit_cast(int, v), 0x141, 0xf, 0xf, true));
    v += __builtin_bit_cast(float, __builtin_amdgcn_update_dpp(0, __builtin_bit_cast(int, v), 0x140, 0xf, 0xf, true));
    return v;
}
struct ScanRegs { uint2 r, k, kk, e, ai; unsigned v; };
__device__ __forceinline__ void scan_phase(const AV& a, LAS unsigned char* lds, int j) {
    const int tid = otid(a);
    const int st = tid >> 4, part = tid & 15;
    const bf16_t* RB = (const bf16_t*)(a.ws() + WS_B); const bf16_t* KB = RB + TOK512; const bf16_t* VB = RB + 2 * TOK512; const bf16_t* KKB = RB + 3 * TOK512;
    for (int it = obid(); it < 256; it += gridDim.x) {
        const int half = it & 1, cb = it >> 1, dir = cb & 1, h = (cb >> 1) & 7, b = cb >> 4;
        const bf16_t* LR = (const bf16_t*)(a.ws() + WS_A) + dir * 512 + h * 64 + 4 * part;
        float* Y = (float*)(a.ws() + WS_B + (dir ? B_Y1 : B_Y0));
        const f32x4 w0 = *(const f32x4*)(a.in(I_W0) + j * 1024 + dir * 512 + h * 64 + 4 * part), a0 = *(const f32x4*)(a.in(I_A0) + j * 1024 + dir * 512 + h * 64 + 4 * part),
                    ka = *(const f32x4*)(a.in(I_KA) + j * 512 + h * 64 + 4 * part);
        auto tok = [&](int ck, int s_) -> size_t {
            if (ck < 8) { const int t = 32 * ck + s_; return (size_t)ML + b * CTXL + (dir ? (CTXL - 1 - t) : t); }
            const int t = 32 * (ck - 8) + s_; return (size_t)b * SEQ + (dir ? (SEQ - 1 - t) : t); };
        auto gload = [&](ScanRegs& g, int ck) {
            const size_t m = tok(ck, st); const size_t o = m * 512 + h * 64 + 4 * part;
            g.r = *(const uint2*)(RB + o); g.k = *(const uint2*)(KB + o); g.kk = *(const uint2*)(KKB + o);
            g.e = *(const uint2*)(LR + m * NLR); g.ai = *(const uint2*)(LR + m * NLR + 1024);
            g.v = *(const unsigned*)(VB + m * 512 + h * 64 + 32 * half + 2 * part); };
        auto gstore = [&](const ScanRegs& g, LAS unsigned char* buf) {
            const f32x4 r = {bflo(g.r.x), bfhi(g.r.x), bflo(g.r.y), bfhi(g.r.y)}, k = {bflo(g.k.x), bfhi(g.k.x), bflo(g.k.y), bfhi(g.k.y)},
                        kk = {bflo(g.kk.x), bfhi(g.kk.x), bflo(g.kk.y), bfhi(g.kk.y)};
            f32x4 e = {bflo(g.e.x), bfhi(g.e.x), bflo(g.e.y), bfhi(g.e.y)}, ai = {bflo(g.ai.x), bfhi(g.ai.x), bflo(g.ai.y), bfhi(g.ai.y)};
            f32x4 w, bb, kd;
#pragma unroll
            for (int i = 0; i < 4; ++i) { const float ee = 0.60653065971263342f * sigmoidf_(e[i] + w0[i]); const float aa = sigmoidf_(ai[i] + a0[i]);
                w[i] = __expf(-ee); bb[i] = kk[i] * aa; kd[i] = k[i] * (1.f + (aa - 1.f) * ka[i]); }
            LAS float* op = (LAS float*)(buf + st * 1280) + 4 * part;
            *(LAS f32x4*)(op) = kk; *(LAS f32x4*)(op + 64) = w; *(LAS f32x4*)(op + 128) = bb; *(LAS f32x4*)(op + 192) = kd; *(LAS f32x4*)(op + 256) = r;
            LAS float* vp = (LAS float*)(buf + SC_OPS) + st * 32 + 2 * part; vp[0] = bflo(g.v); vp[1] = bfhi(g.v); };
        ScanRegs g; gload(g, 0); gstore(g, lds);
        __syncthreads();
        f32x4 S = {0.f, 0.f, 0.f, 0.f};
        LAS float* ybuf = (LAS float*)(lds + SC_YOFF);
        for (int ck = 0; ck < 72; ++ck) {
            if (ck + 1 < 72) gload(g, ck + 1);
            LAS const unsigned char* buf = lds + (ck & 1) * SC_BUF;
#pragma unroll 4
            for (int s_ = 0; s_ < SC_TS; ++s_) {
                LAS const float* op = (LAS const float*)(buf + s_ * 1280) + 4 * part;
                const f32x4 kk = *(LAS const f32x4*)(op), w = *(LAS const f32x4*)(op + 64), bb = *(LAS const f32x4*)(op + 128), kd = *(LAS const f32x4*)(op + 192), r = *(LAS const f32x4*)(op + 256);
                const float vv = ((LAS const float*)(buf + SC_OPS))[s_ * 32 + st];
                float d = (S[0] * kk[0] + S[1] * kk[1]) + (S[2] * kk[2] + S[3] * kk[3]);
                d = dpp_sum16(d);
                const float sa = -d;
                S = S * w + bb * sa + kd * vv;
                float y = (S[0] * r[0] + S[1] * r[1]) + (S[2] * r[2] + S[3] * r[3]);
                y = dpp_sum16(y);
                if (part == 0) ybuf[s_ * 32 + st] = y;
            }
            __syncthreads();
            if (ck + 1 < 72) gstore(g, lds + ((ck + 1) & 1) * SC_BUF);
            { const size_t m = tok(ck, st); const float y0 = ybuf[st * 32 + 2 * part], y1 = ybuf[st * 32 + 2 * part + 1];
              *(float2*)(Y + m * 512 + h * 64 + 32 * half + 2 * part) = make_float2(y0, y1); }
            __syncthreads();
        }
    }
}
enum { OP_SETUP = 0, OP_NORM0, OP_GEMM_IN, OP_PREP1, OP_GEMM_LORA, OP_SCAN, OP_RWKVOUT, OP_QKNORM, OP_ATTNCD, OP_GEMM_OUT, OP_NORM_H, OP_GEMM_FF1, OP_GEMM_FF2, OP_NORM_K };
__device__ __forceinline__ void decode_phase(int ph, int& layer, int& op) {
    if (ph < 2) { layer = 0; op = ph; return; }
    int r = ph - 2; layer = 0;
    if (r >= 10) { r -= 10; layer = 1; if (r >= 8) { r -= 8; layer = 2; if (r >= 10) { r -= 10; layer = 3; } } }
    if ((layer & 1) == 0) { const int t[10] = {OP_GEMM_IN, OP_PREP1, OP_GEMM_LORA, OP_SCAN, OP_RWKVOUT, OP_GEMM_OUT, OP_NORM_H, OP_GEMM_FF1, OP_GEMM_FF2, OP_NORM_K}; op = OP_GEMM_IN;
#pragma unroll
        for (int q = 0; q < 10; ++q) if (r == q) op = t[q]; }
    else { const int t[8] = {OP_GEMM_IN, OP_QKNORM, OP_ATTNCD, OP_GEMM_OUT, OP_NORM_H, OP_GEMM_FF1, OP_GEMM_FF2, OP_NORM_K}; op = OP_GEMM_IN;
#pragma unroll
        for (int q = 0; q < 8; ++q) if (r == q) op = t[q]; }
}
__global__ void __launch_bounds__(NTHR, 2) trunk_fwd(Args a_) {
    extern __shared__ __attribute__((aligned(16))) unsigned char lds_raw[];
    LAS unsigned char* lds = (LAS unsigned char*)lds_raw;
    cg::grid_group grid = cg::this_grid();
    const int lo = a_.ph_lo, hi = a_.ph_hi;
    const int wv_ = __builtin_amdgcn_readfirstlane((int)threadIdx.x >> 6);
    const int G = gridDim.x;
    for (int ph = lo; ph < hi; ++ph) {
        int z_; asm volatile("s_mov_b32 %0, 0" : "=s"(z_)); const AV a{a_, z_, wv_};
        int layer, op; decode_phase(ph, layer, op);
        const bool even = (layer & 1) == 0; const int j = layer >> 1; const bool need_ctx = layer < 3;
        const int Mrows = need_ctx ? MT : ML;
        float* MOD = (float*)(a.ws() + WS_MOD); const float* modl = MOD + (size_t)layer * 9 * 6144;
        bf16_t* UMIX = (bf16_t*)(a.ws() + WS_UMIX);
        if (op == OP_SETUP) { mod_phase(a, lds); rope_phase(a); wconv_phase(a, lds, 0); }
        else if (op == OP_NORM0 || op == OP_NORM_H || op == OP_NORM_K) {
            NormJob jb;
            if (op == OP_NORM0) { jb.rows = MT; jb.o_src = nullptr; jb.gate = nullptr; jb.gpost = nullptr; jb.h_in_input = true; jb.write_h = false;
                jb.shift = MOD + 0 * 1024; jb.scale = MOD + 1 * 1024; jb.gpre = a.in(I_GPREMIX); }
            else if (op == OP_NORM_H) { jb.rows = Mrows; jb.o_src = (const float*)(a.ws() + WS_A); jb.gate = modl + 2 * 1024; jb.gpost = a.in(I_GPOSTMIX) + layer * D;
                jb.h_in_input = (layer == 0); jb.write_h = true; jb.shift = modl + 3 * 1024; jb.scale = modl + 4 * 1024; jb.gpre = a.in(I_GPREFF) + layer * D; }
            else { jb.rows = Mrows; jb.o_src = (const float*)(a.ws() + WS_O2); jb.gate = modl + 5 * 1024; jb.gpost = a.in(I_GPOSTFF) + layer * D; jb.h_in_input = false; jb.write_h = true;
                if (layer < 3) { const float* modn = modl + 9 * 6144; jb.shift = modn + 0 * 1024; jb.scale = modn + 1 * 1024; jb.gpre = a.in(I_GPREMIX) + (layer + 1) * D; }
                else { jb.shift = nullptr; jb.scale = nullptr; jb.gpre = nullptr; } }
            norm_phase(a, jb);
            if (op == OP_NORM_K && layer < 3) wconv_phase(a, lds, layer + 1);
        }
        else if (op == OP_GEMM_IN || op == OP_GEMM_LORA || op == OP_GEMM_FF1) {
            pg8::Gemm g; bf16_t* O; int ldc;
            if (op == OP_GEMM_IN) { const int NP = even ? NPE : NPO; g = pg8::Gemm{UMIX, (const bf16_t*)(a.ws() + WS_W + W_IN), MT, NP, D, D}; O = (bf16_t*)(a.ws() + WS_A); ldc = NP; }
            else if (op == OP_GEMM_LORA) { g = pg8::Gemm{UMIX, (const bf16_t*)(a.ws() + WS_W + W_L), MT, NLR, 384, 1024}; O = (bf16_t*)(a.ws() + WS_A); ldc = NLR; }
            else { g = pg8::Gemm{UMIX, (const bf16_t*)(a.ws() + WS_W + W_1), Mrows, FF, D, D}; O = (bf16_t*)(a.ws() + WS_A); ldc = FF; }
            pg8::StaticOrder S; S.init(g.M, g.N, G, obid());
            pg8::EpiBf16 E{O, ldc, op == OP_GEMM_FF1};
            pg8::gemm_phase<pg8::EpiBf16, pg8::StaticOrder, true, true>(lds, g, S, E, otid(a));
        }
        else if (op == OP_GEMM_OUT || op == OP_GEMM_FF2) {
            pg8::Gemm g; float* O;
            if (op == OP_GEMM_OUT) { g = pg8::Gemm{UMIX, (const bf16_t*)(a.ws() + WS_W + W_OUT), Mrows, D, D, D}; O = (float*)(a.ws() + WS_A); }
            else { g = pg8::Gemm{(const bf16_t*)(a.ws() + WS_A), (const bf16_t*)(a.ws() + WS_W + W_2), Mrows, D, FF, FF}; O = (float*)(a.ws() + WS_O2); }
            pg8::StaticOrder S; S.init(g.M, g.N, G, obid());
            pg8::EpiF32 E{O, D};
            pg8::gemm_phase<pg8::EpiF32, pg8::StaticOrder, true, true>(lds, g, S, E, otid(a));
        }
        else if (op == OP_PREP1) prep1_phase(a, j);
        else if (op == OP_SCAN) { scan_phase(a, lds, j); attnB_phase(a, lds, j, need_ctx); }
        else if (op == OP_RWKVOUT) rwkv_out_phase(a, j);
        else if (op == OP_QKNORM) qknorm_phase(a, j);
        else if (op == OP_ATTNCD) attnCD_phase(a, lds, j, need_ctx);
        if (ph + 1 < hi) grid.sync();
    }
}

#ifndef N_LAUNCH_MODE
#define N_LAUNCH_MODE 1
#endif
extern "C" void kernel_launch(void* const* d_in, const int* in_sizes, int n_in, void* d_out, int out_size, void* d_ws, size_t ws_size, hipStream_t stream) {
    static int grid = 0;
    if (grid == 0) {
        if (n_in != N_IN || out_size != ML * D || ws_size < WS_END) { fprintf(stderr, "kernel_launch: unexpected shapes (n_in %d out %d ws %zu need %zu)\n", n_in, out_size, ws_size, (size_t)WS_END); grid = -1; return; }
        int dev = 0, cus = 0, per_cu = 0;
        (void)hipGetDevice(&dev); (void)hipDeviceGetAttribute(&cus, hipDeviceAttributeMultiprocessorCount, dev);
        (void)hipFuncSetAttribute((const void*)trunk_fwd, hipFuncAttributeMaxDynamicSharedMemorySize, LDS_BYTES);
        (void)hipOccupancyMaxActiveBlocksPerMultiprocessor(&per_cu, (const void*)trunk_fwd, NTHR, LDS_BYTES);
        if (per_cu < 1) per_cu = 1;
        grid = cus;
        fprintf(stderr, "kernel_launch: cus %d per_cu %d grid %d ws %zu\n", cus, per_cu, grid, ws_size);
    }
    if (grid < 0) return;
    Args a{};
    for (int i = 0; i < N_IN; ++i) a.in[i] = (const float*)d_in[i];
    a.out = (float*)d_out; a.ws = (unsigned char*)d_ws;
#if N_LAUNCH_MODE == 1
    a.ph_lo = 0; a.ph_hi = NPH;
    void* args[] = {&a};
    hipError_t e = hipLaunchCooperativeKernel((const void*)trunk_fwd, dim3(grid), dim3(NTHR), args, LDS_BYTES, stream);
    if (e != hipSuccess) fprintf(stderr, "cooperative launch failed: %s\n", hipGetErrorString(e));
#else
    for (int p = 0; p < NPH; ++p) { a.ph_lo = p; a.ph_hi = p + 1; hipLaunchKernelGGL(trunk_fwd, dim3(grid), dim3(NTHR), LDS_BYTES, stream, a); }
#endif
}
```

```cpp
#include <hip/hip_runtime.h>
#include <hip/hip_cooperative_groups.h>
#include <cstdio>
#include <cstdint>
namespace cg = cooperative_groups;

namespace pg8 {
#define PG8_LAS __attribute__((address_space(3)))
typedef unsigned short bf16_t;
typedef short bf16x8 __attribute__((ext_vector_type(8)));
typedef float f32x4 __attribute__((ext_vector_type(4)));
typedef unsigned u32x4 __attribute__((ext_vector_type(4)));
constexpr int BM = 256, BK = 64, HALF = 128, HTB = HALF * BK * 2  , STAGE_BYTES = 8 * HTB, NXCD = 8, WGM = 8;

__host__ __device__ __forceinline__ int lds_byte(int r, int c) { const int st = (r >> 4) * 2 + (c >> 5), rr = r & 15, cc = c & 31, ob = rr * 64 + cc * 2; return st * 1024 + (ob ^ (((ob >> 9) & 1) << 5)); }
__host__ __device__ __forceinline__ void stage_rc(int b, int& R, int& C) { const int st = b / 1024, sb = b % 1024, swz = sb ^ (((sb >> 9) & 1) << 5); R = (st >> 1) * 16 + swz / 64; C = (st & 1) * 32 + (swz % 64) / 2; }
__host__ __device__ __forceinline__ int perm32(int rho) { const int n = rho >> 4, i = rho & 15; return 8 * (i >> 2) + 4 * n + (i & 3); }

struct Unit { int pm, pn; };
struct Gemm { const bf16_t* A; const bf16_t* Bt; int M, N, K, lda; };

struct StaticOrder {
    int nM, nN, nwg, G, c;
    __host__ __device__ void init(int M, int N, int G_, int c_) { nM = M / BM; nN = N / BM; nwg = nM * nN; G = G_; c = c_; }
    __host__ __device__ bool next(int i, Unit& u) const {
        const long L = (long)i * G + c; if (L >= nwg) return false;
        int wgid = (int)L; { const int q = nwg / NXCD, r = nwg % NXCD, xcd = wgid % NXCD, off = wgid / NXCD; wgid = (xcd < r ? xcd * (q + 1) : r * (q + 1) + (xcd - r) * q) + off; }
        const int nig = WGM * nN, gid = wgid / nig, fm = gid * WGM, gsz = (nM - fm) < WGM ? (nM - fm) : WGM;
        u.pm = fm + ((wgid % nig) % gsz); u.pn = (wgid % nig) / gsz; return true;
    }
    __device__ __forceinline__ void a_ready(const Unit&) const {}
    __device__ __forceinline__ void done(const Unit&) const {}
};

__device__ __forceinline__ unsigned cvt_pk_bf16(float lo, float hi) { unsigned r; asm volatile("v_cvt_pk_bf16_f32 %0, %1, %2" : "=v"(r) : "v"(lo), "v"(hi)); return r; }

struct EpiBf16 {
    static constexpr bool PERM = true, AFTER_DRAIN = false;
    bf16_t* O; int ldc; bool sq;
    __device__ __forceinline__ void operator()(const f32x4 (&acc)[2][2][4][2], const Unit& u, int wr, int wc, int fr, int fq) const {
        const int row0 = u.pm * BM + wr * 64 + fr; const int col0 = u.pn * BM + wc * 32 + 8 * fq;
#pragma unroll
        for (int ai = 0; ai < 2; ++ai)
#pragma unroll
            for (int m = 0; m < 4; ++m) { bf16_t* rowp = O + (size_t)(row0 + ai * HALF + m * 16) * ldc + col0;
#pragma unroll
                for (int bj = 0; bj < 2; ++bj) { f32x4 v0 = acc[ai][bj][m][0], v1 = acc[ai][bj][m][1];
                    if (sq) {
#pragma unroll
                        for (int e = 0; e < 4; ++e) { float a = fmaxf(v0[e], 0.f), b = fmaxf(v1[e], 0.f); v0[e] = a * a; v1[e] = b * b; } }
                    u32x4 w; w.x = cvt_pk_bf16(v0[0], v0[1]); w.y = cvt_pk_bf16(v0[2], v0[3]); w.z = cvt_pk_bf16(v1[0], v1[1]); w.w = cvt_pk_bf16(v1[2], v1[3]);
                    *(u32x4*)(rowp + bj * HALF) = w; } }
    }
};

struct EpiF32 {
    static constexpr bool PERM = false, AFTER_DRAIN = false;
    float* C; int ldc;
    __device__ __forceinline__ void operator()(const f32x4 (&acc)[2][2][4][2], const Unit& u, int wr, int wc, int fr, int fq) const {
        const int row0 = u.pm * BM + wr * 64 + fr, col0 = u.pn * BM + wc * 32 + 4 * fq;
#pragma unroll
        for (int ai = 0; ai < 2; ++ai)
#pragma unroll
            for (int m = 0; m < 4; ++m) { float* rowp = C + (size_t)(row0 + ai * HALF + m * 16) * ldc + col0;
#pragma unroll
                for (int bj = 0; bj < 2; ++bj)
#pragma unroll
                    for (int n = 0; n < 2; ++n) *(f32x4*)(rowp + bj * HALF + n * 16) = acc[ai][bj][m][n]; }
    }
};


template <class Epi, class Sched, bool ALIGN_EPI = false, bool SP2 = false>
__device__ __forceinline__ void gemm_phase(PG8_LAS unsigned char* lds, const Gemm g, const Sched& S, const Epi& E, const int tid_in) {
    int tid_ = tid_in; asm volatile("" : "+v"(tid_));
    const int tid = tid_, wid = __builtin_amdgcn_readfirstlane(tid >> 6), lane = tid & 63, wr = wid >> 2, wc = wid & 3, fr = lane & 15, fq = lane >> 4;
    const int K = g.K, nt = K / BK;
    unsigned voffA[2], voffB[2];
#pragma unroll
    for (int i = 0; i < 2; ++i) { int R, C; stage_rc(tid * 16 + i * 8192, R, C); const int Rb = Epi::PERM ? ((R & ~31) + perm32(R & 31)) : R;
        voffA[i] = (unsigned)(R * g.lda + C) * 2u; voffB[i] = (unsigned)(Rb * K + C) * 2u; }
    const size_t kstep = (size_t)(BK * 2);
    const size_t hstepA = (size_t)HALF * g.lda * 2, hstepB = (size_t)HALF * K * 2;
    const size_t tstepA = 2 * hstepA, tstepB = 2 * hstepB;
    const unsigned ldsw = (unsigned)wid * 1024u;
    const int aoff = lds_byte(wr * 64 + fr, fq * 8), boff = lds_byte(wc * 32 + fr, fq * 8);
#define PG8_SA(b, h) (((b) * 2 + (h)) * HTB)
#define PG8_SB(b, h) ((4 + (b) * 2 + (h)) * HTB)
#define PG8_STAGE(bufoff, gbase, voff) do { _Pragma("unroll") for (int _i = 0; _i < 2; ++_i) \
        __builtin_amdgcn_global_load_lds((const unsigned*)((const char*)(gbase) + (voff)[_i]), (PG8_LAS unsigned*)(lds + (bufoff) + ldsw + _i * 8192), 16, 0, 0); } while (0)
#define PG8_LDA(dst, b, h) do { _Pragma("unroll") for (int m = 0; m < 4; ++m) _Pragma("unroll") for (int k = 0; k < 2; ++k) dst[m][k] = *(const PG8_LAS bf16x8*)(lds + PG8_SA(b, h) + aoff + m * 2048 + k * 1024); } while (0)
#define PG8_LDB(dst, b, h) do { _Pragma("unroll") for (int n = 0; n < 2; ++n) _Pragma("unroll") for (int k = 0; k < 2; ++k) dst[n][k] = *(const PG8_LAS bf16x8*)(lds + PG8_SB(b, h) + boff + n * 2048 + k * 1024); } while (0)
#define PG8_MMA(ai, bj, At, Bt) do { __builtin_amdgcn_s_setprio(1); _Pragma("unroll") for (int m = 0; m < 4; ++m) _Pragma("unroll") for (int n = 0; n < 2; ++n) _Pragma("unroll") for (int k = 0; k < 2; ++k) \
        acc[ai][bj][m][n] = __builtin_amdgcn_mfma_f32_16x16x32_bf16(Bt[n][k], At[m][k], acc[ai][bj][m][n], 0, 0, 0); __builtin_amdgcn_s_setprio(0); } while (0)
#define PG8_WAIT_V(n) asm volatile("s_waitcnt vmcnt(" #n ")" ::: "memory")
#define PG8_WAIT_L(n) asm volatile("s_waitcnt lgkmcnt(" #n ")" ::: "memory")
#define PG8_BAR __builtin_amdgcn_s_barrier()
#define PG8_SCHED __builtin_amdgcn_sched_barrier(0)
    Unit cur, nxt; int ui = 0;
    if (!S.next(0, cur)) return;
    f32x4 acc[2][2][4][2];
#pragma unroll
    for (int a = 0; a < 2; ++a)
#pragma unroll
        for (int b = 0; b < 2; ++b)
#pragma unroll
            for (int m = 0; m < 4; ++m)
#pragma unroll
                for (int n = 0; n < 2; ++n) acc[a][b][m][n] = (f32x4){0.f, 0.f, 0.f, 0.f};
    bf16x8 At[4][2], B0[2][2], B1[2][2];
    const char* cA = (const char*)g.A + (size_t)cur.pm * tstepA; const char* cB = (const char*)g.Bt + (size_t)cur.pn * tstepB;
    S.a_ready(cur);
    if constexpr (SP2) {
        PG8_STAGE(PG8_SB(0, 0), cB, voffB); PG8_STAGE(PG8_SB(0, 1), cB + hstepB, voffB); PG8_STAGE(PG8_SA(0, 0), cA, voffA); PG8_STAGE(PG8_SA(0, 1), cA + hstepA, voffA);
        if (wr == 1) PG8_BAR;
        PG8_WAIT_V(2); PG8_BAR;
        PG8_STAGE(PG8_SB(1, 0), cB + kstep, voffB); PG8_STAGE(PG8_SA(1, 0), cA + kstep, voffA); PG8_STAGE(PG8_SB(1, 1), cB + hstepB + kstep, voffB);
        PG8_WAIT_V(6); PG8_BAR;
    } else {
        PG8_STAGE(PG8_SB(0, 0), cB, voffB); PG8_STAGE(PG8_SA(0, 0), cA, voffA); PG8_STAGE(PG8_SB(0, 1), cB + hstepB, voffB); PG8_STAGE(PG8_SA(0, 1), cA + hstepA, voffA);
        if (wr == 1) PG8_BAR;
        PG8_WAIT_V(4); PG8_BAR;
        PG8_STAGE(PG8_SB(1, 0), cB + kstep, voffB); PG8_STAGE(PG8_SA(1, 0), cA + kstep, voffA); PG8_STAGE(PG8_SB(1, 1), cB + hstepB + kstep, voffB);
        PG8_WAIT_V(6); PG8_BAR;
    }
    for (;;) {
        const bool has_next = S.next(ui + 1, nxt);
        const char* nA = has_next ? (const char*)g.A + (size_t)nxt.pm * tstepA : cA; const char* nB = has_next ? (const char*)g.Bt + (size_t)nxt.pn * tstepB : cB;
        for (int t = 0; t < nt; t += 2) {
            const bool last = (t == nt - 2);
            const char* a1 = cA + (size_t)(t + 1) * kstep;
            const char* a2 = last ? nA : cA + (size_t)(t + 2) * kstep; const char* b2 = last ? nB : cB + (size_t)(t + 2) * kstep;
            const char* a3 = a2 + kstep; const char* b3 = b2 + kstep;
            if (last && has_next) S.a_ready(nxt);
            if constexpr (SP2) {
            PG8_LDB(B0, 0, 0); PG8_LDB(B1, 0, 1); PG8_SCHED; PG8_LDA(At, 0, 0); PG8_STAGE(PG8_SA(1, 1), a1 + hstepA, voffA);
            PG8_WAIT_V(8); PG8_WAIT_L(0); PG8_BAR; PG8_MMA(0, 0, At, B0); PG8_MMA(0, 1, At, B1); PG8_BAR; PG8_SCHED;
            PG8_LDA(At, 0, 1); PG8_STAGE(PG8_SB(0, 0), b2, voffB); PG8_STAGE(PG8_SB(0, 1), b2 + hstepB, voffB); PG8_STAGE(PG8_SA(0, 0), a2, voffA);
            PG8_WAIT_V(8); PG8_WAIT_L(0); PG8_BAR; PG8_MMA(1, 0, At, B0); PG8_MMA(1, 1, At, B1); PG8_BAR; PG8_SCHED;
            PG8_LDB(B0, 1, 0); PG8_LDB(B1, 1, 1); PG8_SCHED; PG8_LDA(At, 1, 0); PG8_STAGE(PG8_SA(0, 1), a2 + hstepA, voffA);
            PG8_WAIT_V(8); PG8_WAIT_L(0); PG8_BAR; PG8_MMA(0, 0, At, B0); PG8_MMA(0, 1, At, B1); PG8_BAR; PG8_SCHED;
            PG8_LDA(At, 1, 1); PG8_STAGE(PG8_SB(1, 0), b3, voffB); PG8_STAGE(PG8_SB(1, 1), b3 + hstepB, voffB); PG8_STAGE(PG8_SA(1, 0), a3, voffA);
            PG8_WAIT_V(8); PG8_WAIT_L(0); PG8_BAR; PG8_MMA(1, 0, At, B0); PG8_MMA(1, 1, At, B1); PG8_BAR; PG8_SCHED;
            } else {
            PG8_LDB(B0, 0, 0); PG8_SCHED; PG8_LDA(At, 0, 0); PG8_STAGE(PG8_SA(1, 1), a1 + hstepA, voffA);
            PG8_WAIT_L(8); PG8_BAR; PG8_WAIT_L(0); PG8_MMA(0, 0, At, B0); PG8_BAR; PG8_SCHED;
            PG8_LDB(B1, 0, 1); PG8_STAGE(PG8_SB(0, 0), b2, voffB);
            PG8_BAR; PG8_WAIT_L(0); PG8_MMA(0, 1, At, B1); PG8_BAR;
            PG8_LDA(At, 0, 1); PG8_STAGE(PG8_SA(0, 0), a2, voffA);
            PG8_BAR; PG8_WAIT_L(0); PG8_MMA(1, 0, At, B0); PG8_BAR; PG8_SCHED;
            PG8_STAGE(PG8_SB(0, 1), b2 + hstepB, voffB);
            PG8_WAIT_V(6); PG8_BAR; PG8_MMA(1, 1, At, B1); PG8_BAR;
            PG8_LDB(B0, 1, 0); PG8_SCHED; PG8_LDA(At, 1, 0); PG8_STAGE(PG8_SA(0, 1), a2 + hstepA, voffA);
            PG8_WAIT_L(8); PG8_BAR; PG8_WAIT_L(0); PG8_MMA(0, 0, At, B0); PG8_BAR; PG8_SCHED;
            PG8_LDB(B1, 1, 1); PG8_STAGE(PG8_SB(1, 0), b3, voffB);
            PG8_BAR; PG8_WAIT_L(0); PG8_MMA(0, 1, At, B1); PG8_BAR;
            PG8_LDA(At, 1, 1); PG8_STAGE(PG8_SA(1, 0), a3, voffA);
            PG8_BAR; PG8_WAIT_L(0); PG8_MMA(1, 0, At, B0); PG8_BAR; PG8_SCHED;
            PG8_STAGE(PG8_SB(1, 1), b3 + hstepB, voffB);
            PG8_WAIT_V(6); PG8_BAR; PG8_MMA(1, 1, At, B1); PG8_BAR;
            }
        }
        if constexpr (ALIGN_EPI) { if (wr == 0) PG8_BAR; }
        if constexpr (!Epi::AFTER_DRAIN) { E(acc, cur, wr, wc, fr, fq); S.done(cur); }
        if (!has_next) break;
#pragma unroll
        for (int a = 0; a < 2; ++a)
#pragma unroll
            for (int b = 0; b < 2; ++b)
#pragma unroll
                for (int m = 0; m < 4; ++m)
#pragma unroll
                    for (int n = 0; n < 2; ++n) acc[a][b][m][n] = (f32x4){0.f, 0.f, 0.f, 0.f};
        cur = nxt; cA = nA; cB = nB; ++ui;
        if constexpr (ALIGN_EPI) { if (wr == 1) PG8_BAR; }
    }
    PG8_WAIT_V(0);
    if constexpr (!ALIGN_EPI) { if (wr == 0) PG8_BAR; }
    PG8_BAR;
    if constexpr (Epi::AFTER_DRAIN) { E.fused(acc, cur, wr, wc, fr, fq, lds, wid, lane); S.done(cur); }
#undef PG8_SA
#undef PG8_SB
#undef PG8_STAGE
#undef PG8_LDA
#undef PG8_LDB
#undef PG8_MMA
#undef PG8_WAIT_V
#undef PG8_WAIT_L
#undef PG8_BAR
#undef PG8_SCHED
}
}

#define LAS __attribute__((address_space(3)))
typedef unsigned short bf16_t;
typedef float f32x4 __attribute__((ext_vector_type(4)));
constexpr int D = 1024, NB = 8, SEQ = 2048, CTXL = 256, FF = 4096, HD = 64;
constexpr int ML = NB * SEQ, MC = NB * CTXL, MT = ML + MC;
constexpr int NPE = 2816, NPO = 2304, AIN = 1920;
constexpr int NWAVES = 8, NTHR = 512;
constexpr int LDS_BYTES = 147456;
constexpr float NORM_EPS = 1e-6f, GN_EPS = 64e-5f, LOG2E = 1.4426950408889634f;
constexpr size_t MiB = 1u << 20;
constexpr size_t WS_MOD = 1 * MiB, WS_ROPE = 2 * MiB, WS_W = 3 * MiB, WS_HCTX = 29 * MiB, WS_UMIX = 37 * MiB, WS_A = 73 * MiB, WS_B = 172 * MiB,
                 WS_QKVB = 316 * MiB, WS_END = 343 * MiB;
constexpr size_t W_IN = 0, W_OUT = 6 * MiB, W_1 = 8 * MiB, W_2 = 16 * MiB, W_L = 24 * MiB;
constexpr size_t TOK512 = (size_t)MT * 512;
constexpr size_t B_Y0 = 72 * MiB, B_Y1 = 108 * MiB; constexpr int NLR = 2560;
constexpr size_t WS_O2 = 217 * MiB;
constexpr int NPH = 38;

enum { I_X = 0, I_C, I_CTX, I_CCTX, I_WADA, I_BADA, I_GPREMIX, I_GPOSTMIX, I_GPREFF, I_GPOSTFF, I_WINE, I_WINO, I_WOUT, I_WFF1, I_WFF2,
       I_MUP, I_MUN, I_W0, I_W2, I_A0, I_A2, I_G2, I_KK, I_KA, I_RK, I_GNW, I_GNB, I_SINK, I_RPB, I_QG, I_KG, N_IN };

struct Args { const float* in[N_IN]; float* out; unsigned char* ws; int ph_lo, ph_hi; };
struct AV { const Args& k; int z; int wv;
    __device__ __forceinline__ const float* in(int i) const { return k.in[i + z]; }
    __device__ __forceinline__ unsigned char* ws() const { return k.ws + z; }
    __device__ __forceinline__ float* out() const { return k.out + z; } };

__device__ __forceinline__ unsigned f2bf(float f) { unsigned u = __float_as_uint(f); return (u + 0x7fffu + ((u >> 16) & 1u)) >> 16; }
__device__ __forceinline__ unsigned pk2(float lo, float hi) { return f2bf(lo) | (f2bf(hi) << 16); }
__device__ __forceinline__ float bflo(unsigned u) { return __uint_as_float(u << 16); }
__device__ __forceinline__ float bfhi(unsigned u) { return __uint_as_float(u & 0xffff0000u); }
__device__ __forceinline__ float bf1(bf16_t h) { return __uint_as_float(((unsigned)h) << 16); }
__device__ __forceinline__ void unpack8(const uint4 u, float (&f)[8]) { f[0] = bflo(u.x); f[1] = bfhi(u.x); f[2] = bflo(u.y); f[3] = bfhi(u.y); f[4] = bflo(u.z); f[5] = bfhi(u.z); f[6] = bflo(u.w); f[7] = bfhi(u.w); }
__device__ __forceinline__ uint4 pack8(const float (&f)[8]) { uint4 u; u.x = pk2(f[0], f[1]); u.y = pk2(f[2], f[3]); u.z = pk2(f[4], f[5]); u.w = pk2(f[6], f[7]); return u; }
__device__ __forceinline__ void ld8f(const float* p, float (&f)[8]) { const float4 a = *(const float4*)p, b = *(const float4*)(p + 4); f[0] = a.x; f[1] = a.y; f[2] = a.z; f[3] = a.w; f[4] = b.x; f[5] = b.y; f[6] = b.z; f[7] = b.w; }
__device__ __forceinline__ int otid(const AV& a) { int l; asm volatile("v_mbcnt_lo_u32_b32 %0, -1, 0\n\tv_mbcnt_hi_u32_b32 %0, -1, %0" : "=v"(l)); return a.wv * 64 + l; }
__device__ __forceinline__ int obid() { int b = blockIdx.x; asm volatile("" : "+s"(b)); return b; }
__device__ __forceinline__ float wave_sum(float v) {
#pragma unroll
    for (int o = 1; o < 64; o <<= 1) v += __shfl_xor(v, o);
    return v;
}
__device__ __forceinline__ float wave_max(float v) {
#pragma unroll
    for (int o = 1; o < 64; o <<= 1) v = fmaxf(v, __shfl_xor(v, o));
    return v;
}
__device__ __forceinline__ float sum8(float v) { v += __shfl_xor(v, 1); v += __shfl_xor(v, 2); v += __shfl_xor(v, 4); return v; }
__device__ __forceinline__ float sigmoidf_(float x) { return 1.f / (1.f + __expf(-x)); }

__device__ __forceinline__ void mod_phase(const AV& a, LAS unsigned char* lds) {
    const int tid = otid(a), lane = tid & 63, wave = tid >> 6;
    LAS float* sl = (LAS float*)lds;
    LAS float* red = (LAS float*)(lds + 36864);
    for (int i = tid; i < 9 * 1024; i += NTHR) { const float v = (i < 8192) ? a.in(I_C)[i] : a.in(I_CCTX)[i - 8192]; sl[i] = v / (1.f + __expf(-v)); }
    __syncthreads();
    float* MOD = (float*)(a.ws() + WS_MOD);
    for (int it = obid(); it < 4 * 96; it += gridDim.x) {
        const int layer = it / 96, cgp = it % 96;
        const float* W = a.in(I_WADA) + (size_t)layer * 1024 * 6144 + cgp * 64 + lane;
        float acc[9];
#pragma unroll
        for (int r = 0; r < 9; ++r) acc[r] = 0.f;
        const int k0 = wave * 128;
#pragma unroll 8
        for (int k = 0; k < 128; ++k) {
            const float w = W[(size_t)(k0 + k) * 6144];
#pragma unroll
            for (int r = 0; r < 9; ++r) acc[r] += sl[r * 1024 + k0 + k] * w;
        }
#pragma unroll
        for (int r = 0; r < 9; ++r) red[(wave * 9 + r) * 64 + lane] = acc[r];
        __syncthreads();
        for (int o = tid; o < 576; o += NTHR) {
            const int r = o >> 6, cl = o & 63; float s = 0.f;
#pragma unroll
            for (int w = 0; w < 8; ++w) s += red[(w * 9 + r) * 64 + cl];
            const int col = cgp * 64 + cl;
            MOD[(size_t)(layer * 9 + r) * 6144 + col] = s + a.in(I_BADA)[layer * 6144 + col];
        }
        __syncthreads();
    }
}
__device__ __forceinline__ void rope_phase(const AV& a) {
    float2* R = (float2*)(a.ws() + WS_ROPE);
    for (int i = obid() * NTHR + otid(a); i < SEQ * 32; i += gridDim.x * NTHR) {
        const int t = i >> 5, f = i & 31; const float pos = (float)((f < 16) ? (t >> 6) : (t & 63));
        const float inv = exp2f(-(float)(f & 15) * 0.8304820237218406f);
        const float ang = pos * inv; const float k = rintf(ang * 0.15915494309189535f);
        float r = fmaf(-k, 6.28125f, ang); r = fmaf(-k, 0.0019353071795864769f, r);
        R[i] = make_float2(cosf(r), sinf(r));
    }
}

__device__ __forceinline__ void transpose_item(const float* W, int K, int N, bf16_t* WT, LAS float* scr, int item, int lane) {
    const int nblk = N / 32, kb = item / nblk, nb = item % nblk, k0 = 64 * kb, n0 = 32 * nb;
#pragma unroll 8
    for (int i = 0; i < 32; ++i) { const int kk = 2 * i + (lane >> 5); scr[kk * 33 + (lane & 31)] = W[(size_t)(k0 + kk) * N + n0 + (lane & 31)]; }
    asm volatile("s_waitcnt lgkmcnt(0)" ::: "memory");
    const int c = lane & 7;
#pragma unroll
    for (int j = 0; j < 4; ++j) { const int n = (lane >> 3) + 8 * j; const LAS float* s = scr + (8 * c) * 33 + n;
        uint4 o; o.x = pk2(s[0 * 33], s[1 * 33]); o.y = pk2(s[2 * 33], s[3 * 33]); o.z = pk2(s[4 * 33], s[5 * 33]); o.w = pk2(s[6 * 33], s[7 * 33]);
        *(uint4*)(WT + (size_t)(n0 + n) * K + k0 + 8 * c) = o; }
    asm volatile("s_waitcnt lgkmcnt(0)" ::: "memory");
}
__device__ __forceinline__ void wconv_phase(const AV& a, LAS unsigned char* lds, int layer) {
    const int tid = otid(a), lane = tid & 63, wave = tid >> 6;
    LAS float* scr = (LAS float*)(lds + 65536 + wave * 8704);
    const int gw = obid() * NWAVES + wave, NGW = gridDim.x * NWAVES;
    const bool even = (layer & 1) == 0; const int j = layer >> 1;
    const int NIN = even ? 2688 : 2304;
    const float* Win = even ? a.in(I_WINE) + (size_t)j * D * 2688 : a.in(I_WINO) + (size_t)j * D * 2304;
    bf16_t* WinT = (bf16_t*)(a.ws() + WS_W + W_IN); bf16_t* WoT = (bf16_t*)(a.ws() + WS_W + W_OUT); bf16_t* W1T = (bf16_t*)(a.ws() + WS_W + W_1); bf16_t* W2T = (bf16_t*)(a.ws() + WS_W + W_2);
    const int I_in = (D / 64) * (NIN / 32), I_o = (D / 64) * (D / 32), I_1 = (D / 64) * (FF / 32), I_2 = (FF / 64) * (D / 32);
    const int NIT = I_in + I_o + I_1 + I_2;
    for (int it = gw; it < NIT; it += NGW) {
        int r = it;
        if (r < I_in) { transpose_item(Win, D, NIN, WinT, scr, r, lane); continue; } r -= I_in;
        if (r < I_o) { transpose_item(a.in(I_WOUT) + (size_t)layer * D * D, D, D, WoT, scr, r, lane); continue; } r -= I_o;
        if (r < I_1) { transpose_item(a.in(I_WFF1) + (size_t)layer * D * FF, D, FF, W1T, scr, r, lane); continue; } r -= I_1;
        transpose_item(a.in(I_WFF2) + (size_t)layer * FF * D, FF, D, W2T, scr, r, lane);
    }
    if (even) {
        uint4* z = (uint4*)(WinT + (size_t)2688 * D);
        for (int i = obid() * NTHR + tid; i < 128 * D / 8; i += gridDim.x * NTHR) z[i] = make_uint4(0, 0, 0, 0);
        bf16_t* LT = (bf16_t*)(a.ws() + WS_W + W_L);
        const float* w2 = a.in(I_W2) + (size_t)j * 2 * 64 * 512; const float* a2 = a.in(I_A2) + (size_t)j * 2 * 64 * 512; const float* g2 = a.in(I_G2) + (size_t)j * 128 * 512;
        for (int i = obid() * NTHR + tid; i < 2560 * 384; i += gridDim.x * NTHR) {
            const int n = i / 384, k = i % 384; const int arr = n >> 9, ch = n & 511; float v = 0.f;
            if (arr < 2) { if ((k >> 6) == arr) v = w2[((size_t)arr * 64 + (k & 63)) * 512 + ch]; }
            else if (arr < 4) { if ((k >> 6) == arr) v = a2[((size_t)(arr - 2) * 64 + (k & 63)) * 512 + ch]; }
            else { if (k >= 256) v = g2[(size_t)(k - 256) * 512 + ch]; }
            LT[i] = (bf16_t)f2bf(v);
        }
    }
}

struct NormJob {
    int rows;
    const float* o_src;
    const float* gate; const float* gpost;
    bool h_in_input; bool write_h;
    const float* shift; const float* scale; const float* gpre;
};
__device__ __forceinline__ void norm_phase(const AV& a, const NormJob& jb) {
    const int tid = otid(a), lane = tid & 63, wave = tid >> 6;
    const int gw = obid() * NWAVES + wave, NGW = gridDim.x * NWAVES;
    float* hctx = (float*)(a.ws() + WS_HCTX); bf16_t* U = (bf16_t*)(a.ws() + WS_UMIX);
    for (int m = gw; m < jb.rows; m += NGW) {
        const int mb = (m < ML) ? (m >> 11) : 8;
        const float* hin = jb.h_in_input ? ((m < ML) ? a.in(I_X) + (size_t)m * D : a.in(I_CTX) + (size_t)(m - ML) * D)
                                         : ((m < ML) ? a.out() + (size_t)m * D : hctx + (size_t)(m - ML) * D);
        float* hout = (m < ML) ? a.out() + (size_t)m * D : hctx + (size_t)(m - ML) * D;
        f32x4 h[4];
#pragma unroll
        for (int q = 0; q < 4; ++q) h[q] = *(const f32x4*)(hin + 4 * lane + 256 * q);
        if (jb.o_src) {
            f32x4 o[4]; float ss = 0.f;
#pragma unroll
            for (int q = 0; q < 4; ++q) { o[q] = *(const f32x4*)(jb.o_src + (size_t)m * D + 4 * lane + 256 * q); ss += (o[q][0] * o[q][0] + o[q][1] * o[q][1]) + (o[q][2] * o[q][2] + o[q][3] * o[q][3]); }
            const float rms = rsqrtf(wave_sum(ss) * (1.f / D) + NORM_EPS);
#pragma unroll
            for (int q = 0; q < 4; ++q) {
                const f32x4 g = *(const f32x4*)(jb.gate + (size_t)mb * 6144 + 4 * lane + 256 * q), gp = *(const f32x4*)(jb.gpost + 4 * lane + 256 * q);
                h[q] = h[q] + g * (o[q] * rms * gp);
            }
        }
        if (jb.write_h) {
#pragma unroll
            for (int q = 0; q < 4; ++q) *(f32x4*)(hout + 4 * lane + 256 * q) = h[q];
        }
        if (jb.gpre) {
            float ss = 0.f;
#pragma unroll
            for (int q = 0; q < 4; ++q) ss += (h[q][0] * h[q][0] + h[q][1] * h[q][1]) + (h[q][2] * h[q][2] + h[q][3] * h[q][3]);
            const float rms = rsqrtf(wave_sum(ss) * (1.f / D) + NORM_EPS);
#pragma unroll
            for (int q = 0; q < 4; ++q) {
                const int col = 4 * lane + 256 * q;
                const f32x4 gp = *(const f32x4*)(jb.gpre + col), sc = *(const f32x4*)(jb.scale + (size_t)mb * 6144 + col), sh = *(const f32x4*)(jb.shift + (size_t)mb * 6144 + col);
                const f32x4 u = (h[q] * rms * gp) * (sc + 1.f) + sh;
                uint2 w; w.x = pk2(u[0], u[1]); w.y = pk2(u[2], u[3]);
                *(uint2*)(U + (size_t)m * D + col) = w;
            }
        }
    }
}

__device__ __forceinline__ void prep1_phase(const AV& a, int j) {
    const int tid = otid(a), lane = tid & 63, wave = tid >> 6;
    const int gw = obid() * NWAVES + wave, NGW = gridDim.x * NWAVES;
    const bf16_t* P = (const bf16_t*)(a.ws() + WS_A);
    bf16_t* RB = (bf16_t*)(a.ws() + WS_B); bf16_t* KB = RB + TOK512; bf16_t* VB = RB + 2 * TOK512; bf16_t* KKB = RB + 3 * TOK512;
    bf16_t* LA = (bf16_t*)(a.ws() + WS_UMIX);
    bf16_t* QKVB = (bf16_t*)(a.ws() + WS_QKVB);
    const float2* ROPE = (const float2*)(a.ws() + WS_ROPE);
    const float* mup = a.in(I_MUP) + j * AIN; const float* mun = a.in(I_MUN) + j * AIN; const float* k_k = a.in(I_KK) + j * 512;
    for (int m = gw; m < MT; m += NGW) {
        int t, len; if (m < ML) { t = m & (SEQ - 1); len = SEQ; } else { t = (m - ML) & (CTXL - 1); len = CTXL; }
        const bool hasp = t > 0, hasn = t < len - 1;
        const bf16_t* row = P + (size_t)m * NPE;
#pragma unroll
        for (int ps = 0; ps < 4; ++ps) {
            const int col = ps * 512 + lane * 8;
            const bool act = (ps < 3) || (lane < 48);
            float x[8];
            if (act) {
                float c[8], p[8], n[8], mp[8], mn[8];
                unpack8(*(const uint4*)(row + col), c);
                if (hasp) unpack8(*(const uint4*)(row - NPE + col), p); else {
#pragma unroll
                    for (int e = 0; e < 8; ++e) p[e] = 0.f; }
                if (hasn) unpack8(*(const uint4*)(row + NPE + col), n); else {
#pragma unroll
                    for (int e = 0; e < 8; ++e) n[e] = 0.f; }
                ld8f(mup + col, mp); ld8f(mun + col, mn);
#pragma unroll
                for (int e = 0; e < 8; ++e) x[e] = c[e] + mp[e] * (p[e] - c[e]) + mn[e] * (n[e] - c[e]);
            } else {
#pragma unroll
                for (int e = 0; e < 8; ++e) x[e] = 0.f;
            }
            if (ps == 0) *(uint4*)(RB + (size_t)m * 512 + lane * 8) = pack8(x);
            if (ps == 1) {
                *(uint4*)(KB + (size_t)m * 512 + lane * 8) = pack8(x);
                float kkv[8], kw[8]; ld8f(k_k + lane * 8, kw); float ss = 0.f;
#pragma unroll
                for (int e = 0; e < 8; ++e) { kkv[e] = x[e] * kw[e]; ss += kkv[e] * kkv[e]; }
                ss = sum8(ss);
                const float inv = 1.f / fmaxf(sqrtf(ss), 1e-12f);
#pragma unroll
                for (int e = 0; e < 8; ++e) kkv[e] *= inv;
                *(uint4*)(KKB + (size_t)m * 512 + lane * 8) = pack8(kkv);
            }
            if (ps == 2) *(uint4*)(VB + (size_t)m * 512 + lane * 8) = pack8(x);
            if (ps == 3 && act) {
                float y[8];
#pragma unroll
                for (int e = 0; e < 8; ++e) {
                    if (lane < 16) { const float ex = __expf(2.f * x[e]); y[e] = 1.f - 2.f / (ex + 1.f); }
                    else if (lane < 32) y[e] = x[e];
                    else y[e] = sigmoidf_(x[e]);
                }
                *(uint4*)(LA + (size_t)m * 1024 + lane * 8) = pack8(y);
            }
        }
#pragma unroll
        for (int ps = 0; ps < 2; ++ps) {
            const bool act = (ps == 0) || (lane < 32);
            const int col = (ps == 0 ? 1920 : 2432) + lane * 8;
            float x[8];
            if (act) unpack8(*(const uint4*)(row + col), x); else {
#pragma unroll
                for (int e = 0; e < 8; ++e) x[e] = 0.f; }
            float xp[8];
#pragma unroll
            for (int e = 0; e < 8; ++e) xp[e] = __shfl_xor(x[e], 2);
            const bool roped = (m < ML) && (ps == 0 || lane < 16);
            if (roped) {
                const int c8 = lane & 7; const float2* tab = ROPE + (size_t)t * 32 + 16 * (c8 >> 2) + 8 * (c8 & 1);
#pragma unroll
                for (int e = 0; e < 8; ++e) { const float2 cs = tab[e]; x[e] = (c8 & 2) ? (xp[e] * cs.y + x[e] * cs.x) : (x[e] * cs.x - xp[e] * cs.y); }
            }
            if (act) *(uint4*)(QKVB + (size_t)m * 768 + (ps == 0 ? 0 : 512) + lane * 8) = pack8(x);
        }
    }
}

__device__ __forceinline__ void qknorm_phase(const AV& a, int j) {
    const int tid = otid(a), lane = tid & 63, wave = tid >> 6;
    const int gw = obid() * NWAVES + wave, NGW = gridDim.x * NWAVES;
    bf16_t* P = (bf16_t*)(a.ws() + WS_A);
    const float2* ROPE = (const float2*)(a.ws() + WS_ROPE);
    const float* qg = a.in(I_QG) + j * 64; const float* kg = a.in(I_KG) + j * 64;
    for (int m = gw; m < MT; m += NGW) {
        const int t = m & (SEQ - 1);
        bf16_t* row = P + (size_t)m * NPO;
#pragma unroll
        for (int ps = 0; ps < 2; ++ps) {
            const bool act = (ps == 0) || (lane < 16);
            const int col = (ps == 0 ? 1536 : 2048) + lane * 8;
            float x[8];
            if (act) unpack8(*(const uint4*)(row + col), x); else {
#pragma unroll
                for (int e = 0; e < 8; ++e) x[e] = 0.f; }
            float ss = 0.f;
#pragma unroll
            for (int e = 0; e < 8; ++e) ss += x[e] * x[e];
            ss = sum8(ss);
            const float rms = rsqrtf(ss * (1.f / 64.f) + NORM_EPS);
            float g[8]; ld8f((ps == 0 ? qg : kg) + (lane & 7) * 8, g);
#pragma unroll
            for (int e = 0; e < 8; ++e) x[e] = x[e] * rms * g[e];
            float xp[8];
#pragma unroll
            for (int e = 0; e < 8; ++e) xp[e] = __shfl_xor(x[e], 2);
            if (m < ML) {
                const int c8 = lane & 7; const float2* tab = ROPE + (size_t)t * 32 + 16 * (c8 >> 2) + 8 * (c8 & 1);
#pragma unroll
                for (int e = 0; e < 8; ++e) { const float2 cs = tab[e]; x[e] = (c8 & 2) ? (xp[e] * cs.y + x[e] * cs.x) : (x[e] * cs.x - xp[e] * cs.y); }
            }
            if (act) *(uint4*)(row + col) = pack8(x);
        }
    }
}

__device__ __forceinline__ void rwkv_out_phase(const AV& a, int j) {
    const int tid = otid(a), lane = tid & 63, wave = tid >> 6;
    const int gw = obid() * NWAVES + wave, NGW = gridDim.x * NWAVES;
    const float* Y0 = (const float*)(a.ws() + WS_B + B_Y0); const float* Y1 = (const float*)(a.ws() + WS_B + B_Y1);
    const bf16_t* LR = (const bf16_t*)(a.ws() + WS_A);
    const bf16_t* RB = (const bf16_t*)(a.ws() + WS_B); const bf16_t* KB = RB + TOK512; const bf16_t* VB = RB + 2 * TOK512;
    bf16_t* MIX = (bf16_t*)(a.ws() + WS_UMIX);
    const float* k_a = a.in(I_KA) + j * 512; const float* r_k = a.in(I_RK) + j * 512; const float* gnw = a.in(I_GNW) + j * 512; const float* gnb = a.in(I_GNB) + j * 512;
    const int ch = lane * 8;
    float ka[8], rk[8], gw8[8], gb8[8], ab0[8], ab1[8]; ld8f(k_a + ch, ka); ld8f(r_k + ch, rk); ld8f(gnw + ch, gw8); ld8f(gnb + ch, gb8);
    ld8f(a.in(I_A0) + j * 1024 + ch, ab0); ld8f(a.in(I_A0) + j * 1024 + 512 + ch, ab1);
    for (int m = gw; m < MT; m += NGW) {
        const size_t o = (size_t)m * 512 + ch;
        float y[8], y1[8]; ld8f(Y0 + o, y); ld8f(Y1 + o, y1);
        float s = 0.f;
#pragma unroll
        for (int e = 0; e < 8; ++e) { y[e] += y1[e]; s += y[e]; }
        const float mu = sum8(s) * (1.f / 64.f); float q = 0.f;
#pragma unroll
        for (int e = 0; e < 8; ++e) { y[e] -= mu; q += y[e] * y[e]; }
        const float rstd = rsqrtf(sum8(q) * (1.f / 64.f) + GN_EPS);
        float r[8], k[8], v[8], a0[8], a1[8], g[8];
        unpack8(*(const uint4*)(RB + o), r); unpack8(*(const uint4*)(KB + o), k); unpack8(*(const uint4*)(VB + o), v);
        const bf16_t* lr = LR + (size_t)m * NLR + ch;
        unpack8(*(const uint4*)(lr + 1024), a0); unpack8(*(const uint4*)(lr + 1536), a1); unpack8(*(const uint4*)(lr + 2048), g);
#pragma unroll
        for (int e = 0; e < 8; ++e) { a0[e] = sigmoidf_(a0[e] + ab0[e]); a1[e] = sigmoidf_(a1[e] + ab1[e]); }
        float bs = 0.f;
#pragma unroll
        for (int e = 0; e < 8; ++e) { const float kd = k[e] * (1.f + (a0[e] - 1.f) * ka[e]) + k[e] * (1.f + (a1[e] - 1.f) * ka[e]); bs += r[e] * kd * rk[e]; }
        bs = sum8(bs);
        float outv[8];
#pragma unroll
        for (int e = 0; e < 8; ++e) outv[e] = (y[e] * rstd * gw8[e] + gb8[e] + bs * v[e]) * g[e];
        *(uint4*)(MIX + (size_t)m * 1024 + ch) = pack8(outv);
    }
}

__device__ __forceinline__ void scan_naive_phase(const AV& a, int j) {
    const int tid = otid(a), lane = tid & 63, wave = tid >> 6;
    const int gw = obid() * NWAVES + wave, NGW = gridDim.x * NWAVES;
    const bf16_t* RB = (const bf16_t*)(a.ws() + WS_B); const bf16_t* KB = RB + TOK512; const bf16_t* VB = RB + 2 * TOK512; const bf16_t* KKB = RB + 3 * TOK512;
    for (int cq = gw; cq < 512; cq += NGW) {
        const int cb = cq >> 2, rq = cq & 3;
        const int dir = cb & 1, h = (cb >> 1) & 7, b = cb >> 4;
        const int row = rq * 16 + (lane >> 2), part = lane & 3;
        const bf16_t* LR = (const bf16_t*)(a.ws() + WS_A) + dir * 512 + h * 64 + part * 16;
        float* Y = (float*)(a.ws() + WS_B + (dir ? B_Y1 : B_Y0));
        float w0[16], a0[16];
        ld8f(a.in(I_W0) + j * 1024 + dir * 512 + h * 64 + part * 16, *(float(*)[8])&w0[0]); ld8f(a.in(I_W0) + j * 1024 + dir * 512 + h * 64 + part * 16 + 8, *(float(*)[8])&w0[8]);
        ld8f(a.in(I_A0) + j * 1024 + dir * 512 + h * 64 + part * 16, *(float(*)[8])&a0[0]); ld8f(a.in(I_A0) + j * 1024 + dir * 512 + h * 64 + part * 16 + 8, *(float(*)[8])&a0[8]);
        float ka[16]; ld8f(a.in(I_KA) + j * 512 + h * 64 + part * 16, *(float(*)[8])&ka[0]); ld8f(a.in(I_KA) + j * 512 + h * 64 + part * 16 + 8, *(float(*)[8])&ka[8]);
        float S[16];
#pragma unroll
        for (int k = 0; k < 16; ++k) S[k] = 0.f;
        for (int s = 0; s < CTXL + SEQ; ++s) {
            int m;
            if (s < CTXL) m = ML + b * CTXL + (dir ? (CTXL - 1 - s) : s);
            else m = b * SEQ + (dir ? (SEQ - 1 - (s - CTXL)) : (s - CTXL));
            const size_t oh = (size_t)m * 512 + h * 64, o = oh + part * 16;
            const float vv = bf1(VB[oh + row]);
            float kk[16], ee[16], ai[16], kx[16], rr[16];
            unpack8(*(const uint4*)(KKB + o), *(float(*)[8])&kk[0]); unpack8(*(const uint4*)(KKB + o + 8), *(float(*)[8])&kk[8]);
            const bf16_t* lr = LR + (size_t)m * NLR;
            unpack8(*(const uint4*)(lr), *(float(*)[8])&ee[0]);  unpack8(*(const uint4*)(lr + 8), *(float(*)[8])&ee[8]);
            unpack8(*(const uint4*)(lr + 1024), *(float(*)[8])&ai[0]);  unpack8(*(const uint4*)(lr + 1032), *(float(*)[8])&ai[8]);
#pragma unroll
            for (int k = 0; k < 16; ++k) { ee[k] = 0.60653065971263342f * sigmoidf_(ee[k] + w0[k]); ai[k] = sigmoidf_(ai[k] + a0[k]); }
            unpack8(*(const uint4*)(KB + o), *(float(*)[8])&kx[0]);  unpack8(*(const uint4*)(KB + o + 8), *(float(*)[8])&kx[8]);
            unpack8(*(const uint4*)(RB + o), *(float(*)[8])&rr[0]);  unpack8(*(const uint4*)(RB + o + 8), *(float(*)[8])&rr[8]);
            float d = 0.f;
#pragma unroll
            for (int k = 0; k < 16; ++k) d += S[k] * kk[k];
            d += __shfl_xor(d, 1); d += __shfl_xor(d, 2);
            const float sa = -d;
            float y = 0.f;
#pragma unroll
            for (int k = 0; k < 16; ++k) {
                const float w = __expf(-ee[k]), bb = kk[k] * ai[k], kd = kx[k] * (1.f + (ai[k] - 1.f) * ka[k]);
                const float sn = S[k] * w + sa * bb + vv * kd;
                S[k] = sn; y += sn * rr[k];
            }
            y += __shfl_xor(y, 1); y += __shfl_xor(y, 2);
            if (part == 0) Y[oh + row] = y;
        }
    }
}

template <class KF> __device__ __forceinline__ void attn_naive_row(const bf16_t* qp, const KF& kf, int nkeys, bool has_sink, float sink, bf16_t* outp, int lane) {
    float q[64];
#pragma unroll
    for (int c = 0; c < 8; ++c) { float t8[8]; unpack8(*(const uint4*)(qp + c * 8), t8);
#pragma unroll
        for (int e = 0; e < 8; ++e) q[c * 8 + e] = t8[e]; }
    float mrun = -1e30f, lrun = 0.f; float o[64];
#pragma unroll
    for (int d = 0; d < 64; ++d) o[d] = 0.f;
    for (int j = lane; j < nkeys; j += 64) {
        const bf16_t* kp; const bf16_t* vp; float bias;
        if (!kf(j, kp, vp, bias)) continue;
        float s = 0.f;
#pragma unroll
        for (int c = 0; c < 8; ++c) { float t8[8]; unpack8(*(const uint4*)(kp + c * 8), t8);
#pragma unroll
            for (int e = 0; e < 8; ++e) s += q[c * 8 + e] * t8[e]; }
        s = s * 0.125f + bias;
        const float mn = fmaxf(mrun, s), al = __expf(mrun - mn), p = __expf(s - mn);
        lrun = lrun * al + p; mrun = mn;
#pragma unroll
        for (int c = 0; c < 8; ++c) { float t8[8]; unpack8(*(const uint4*)(vp + c * 8), t8);
#pragma unroll
            for (int e = 0; e < 8; ++e) o[c * 8 + e] = o[c * 8 + e] * al + p * t8[e]; }
    }
    float M = wave_max(mrun); if (has_sink) M = fmaxf(M, sink);
    const float sc = __expf(mrun - M);
    const float L = wave_sum(lrun * sc) + (has_sink ? __expf(sink - M) : 0.f);
    float res = 0.f;
#pragma unroll
    for (int d = 0; d < 64; ++d) { const float v = wave_sum(o[d] * sc); if (lane == d) res = v; }
    outp[lane] = (bf16_t)f2bf(res / L);
}

struct KfB {
    const bf16_t* QKVB; int b, t, kvh; bool ctxq;
    __device__ __forceinline__ bool operator()(int j, const bf16_t*& kp, const bf16_t*& vp, float& bias) const {
        bias = 0.f; size_t row;
        if (ctxq) row = (size_t)ML + b * CTXL + j;
        else if (j < 257) { const int kpos = t - 128 + j; if (kpos < 0 || kpos >= SEQ) return false; row = (size_t)b * SEQ + kpos; }
        else row = (size_t)ML + b * CTXL + (j - 257);
        kp = QKVB + row * 768 + 512 + kvh * 64; vp = kp + 128; return true;
    }
};
struct KfC {
    const bf16_t* P; const float* rpb; int b, r, c, h; bool ctxq;
    __device__ __forceinline__ bool operator()(int j, const bf16_t*& kp, const bf16_t*& vp, float& bias) const {
        size_t row; bias = 0.f;
        if (ctxq) row = (size_t)ML + b * CTXL + j;
        else if (j < 128) {
            const int i = j >> 4, jj = j & 15;
            const int kr = min(max(r - 4, 0), 24) + i, kc = min(max(c - 8, 0), 48) + jj;
            const int dr = kr - r + 7, dc = min(max(kc - c + 15, 0), 30);
            bias = rpb[(h * 15 + dr) * 31 + dc];
            row = (size_t)b * SEQ + kr * 64 + kc;
        } else row = (size_t)ML + b * CTXL + (j - 128);
        kp = P + row * NPO + 512 + h * 64; vp = kp + 512; return true;
    }
};
struct KfD {
    const bf16_t* P; int b, kvh; bool ctxq;
    __device__ __forceinline__ bool operator()(int j, const bf16_t*& kp, const bf16_t*& vp, float& bias) const {
        bias = 0.f; const size_t row = (j < CTXL) ? (size_t)ML + b * CTXL + j : (size_t)b * SEQ + (j - CTXL);
        kp = P + row * NPO + 2048 + kvh * 64; vp = kp + 128; return true;
    }
};

__device__ __forceinline__ void attnB_naive_phase(const AV& a, int j, bool need_ctx) {
    const int tid = otid(a), lane = tid & 63, wave = tid >> 6;
    const int gw = obid() * NWAVES + wave, NGW = gridDim.x * NWAVES;
    const bf16_t* QKVB = (const bf16_t*)(a.ws() + WS_QKVB); bf16_t* MIX = (bf16_t*)(a.ws() + WS_UMIX);
    const int rows = need_ctx ? MT : ML;
    for (int it = gw; it < rows * 8; it += NGW) {
        const int m = it >> 3, hq = it & 7;
        KfB kf; kf.QKVB = QKVB; kf.kvh = hq >> 2; kf.ctxq = m >= ML;
        if (m < ML) { kf.b = m >> 11; kf.t = m & (SEQ - 1); } else { kf.b = (m - ML) >> 8; kf.t = 0; }
        attn_naive_row(QKVB + (size_t)m * 768 + hq * 64, kf, kf.ctxq ? CTXL : 257 + CTXL, true, a.in(I_SINK)[j * 8 + hq], MIX + (size_t)m * 1024 + 512 + hq * 64, lane);
    }
}
__device__ __forceinline__ void attnCD_naive_phase(const AV& a, int j, bool need_ctx) {
    const int tid = otid(a), lane = tid & 63, wave = tid >> 6;
    const int gw = obid() * NWAVES + wave, NGW = gridDim.x * NWAVES;
    const bf16_t* P = (const bf16_t*)(a.ws() + WS_A); bf16_t* MIX = (bf16_t*)(a.ws() + WS_UMIX);
    const int rows = need_ctx ? MT : ML;
    for (int it = gw; it < rows * 16; it += NGW) {
        const int m = it >> 4, hh = it & 15;
        const bool ctxq = m >= ML; const int b = ctxq ? (m - ML) >> 8 : m >> 11; const int t = m & (SEQ - 1);
        if (hh < 8) {
            KfC kf; kf.P = P; kf.rpb = a.in(I_RPB) + (size_t)j * 8 * 15 * 31; kf.b = b; kf.r = t >> 6; kf.c = t & 63; kf.h = hh; kf.ctxq = ctxq;
            attn_naive_row(P + (size_t)m * NPO + hh * 64, kf, ctxq ? CTXL : 128 + CTXL, false, 0.f, MIX + (size_t)m * 1024 + hh * 64, lane);
        } else {
            const int hq = hh - 8;
            KfD kf; kf.P = P; kf.b = b; kf.kvh = hq >> 2; kf.ctxq = ctxq;
            attn_naive_row(P + (size_t)m * NPO + 1536 + hq * 64, kf, ctxq ? CTXL : CTXL + SEQ, false, 0.f, MIX + (size_t)m * 1024 + 512 + hq * 64, lane);
        }
    }
}


typedef short bf16x8_t __attribute__((ext_vector_type(8)));
typedef float f32x16_t __attribute__((ext_vector_type(16)));
typedef unsigned u32x4_t __attribute__((ext_vector_type(4)));
typedef unsigned u32x2_t __attribute__((ext_vector_type(2)));
constexpr int AK_PITCH = 144, AV_PITCH = 136, AV_OFF = 64 * AK_PITCH, ABUF = AV_OFF + 64 * AV_PITCH;
constexpr float ATT_SC = 0.125f * LOG2E, NEGBIG = -1e30f;
struct AttnSt { f32x16_t o0, o1; float m2, l; };
struct StageRegs { uint4 a, b; };

__device__ __forceinline__ void attn_load_tile(StageRegs& sr, const bf16_t* base, int pitch, int kcol, int vcol, int tid) {
    if (tid < 256) { const int key = tid >> 3, c = tid & 7; sr.a = *(const uint4*)(base + (size_t)key * pitch + kcol + c * 8); sr.b = *(const uint4*)(base + (size_t)(key + 32) * pitch + kcol + c * 8); }
    else { const int t2 = tid - 256, kp = t2 >> 3, c = t2 & 7; sr.a = *(const uint4*)(base + (size_t)(2 * kp) * pitch + vcol + c * 8); sr.b = *(const uint4*)(base + (size_t)(2 * kp + 1) * pitch + vcol + c * 8); }
}
__device__ __forceinline__ void attn_store_tile(const StageRegs& sr, LAS unsigned char* buf, int tid) {
    if (tid < 256) { const int key = tid >> 3, c = tid & 7; *(LAS u32x4_t*)(buf + key * AK_PITCH + c * 16) = (u32x4_t){sr.a.x, sr.a.y, sr.a.z, sr.a.w}; *(LAS u32x4_t*)(buf + (key + 32) * AK_PITCH + c * 16) = (u32x4_t){sr.b.x, sr.b.y, sr.b.z, sr.b.w}; }
    else {
        const int t2 = tid - 256, kp = t2 >> 3, c = t2 & 7; LAS unsigned char* vt = buf + AV_OFF + (8 * c) * AV_PITCH + kp * 4;
        const unsigned a[4] = {sr.a.x, sr.a.y, sr.a.z, sr.a.w}, b[4] = {sr.b.x, sr.b.y, sr.b.z, sr.b.w};
#pragma unroll
        for (int i = 0; i < 4; ++i) {
            *(LAS unsigned*)(vt + (2 * i) * AV_PITCH) = (a[i] & 0xffffu) | (b[i] << 16);
            *(LAS unsigned*)(vt + (2 * i + 1) * AV_PITCH) = (a[i] >> 16) | (b[i] & 0xffff0000u);
        }
    }
}
template <class SF> __device__ __forceinline__ void attn_subtile(AttnSt& st, const bf16x8_t (&qf)[4], LAS const unsigned char* buf, int koff, int lane, const SF& sf) {
    const int q = lane & 31, h = lane >> 5;
    f32x16_t s;
#pragma unroll
    for (int r = 0; r < 16; ++r) s[r] = 0.f;
    LAS const unsigned char* kp = buf + (koff + q) * AK_PITCH + h * 16;
#pragma unroll
    for (int ds = 0; ds < 4; ++ds) { const bf16x8_t kf = *(LAS const bf16x8_t*)(kp + ds * 32); s = __builtin_amdgcn_mfma_f32_32x32x16_bf16(kf, qf[ds], s, 0, 0, 0); }
    float tm = NEGBIG;
#pragma unroll
    for (int r = 0; r < 16; ++r) { const int key = koff + (r & 3) + 8 * (r >> 2) + 4 * h; s[r] = sf(s[r], key); tm = fmaxf(tm, s[r]); }
    tm = fmaxf(tm, __shfl_xor(tm, 32));
    const float mn = fmaxf(st.m2, tm), alpha = __builtin_amdgcn_exp2f(st.m2 - mn); st.m2 = mn;
    float ps = 0.f;
#pragma unroll
    for (int r = 0; r < 16; ++r) { s[r] = __builtin_amdgcn_exp2f(s[r] - mn); ps += s[r]; }
    st.l = st.l * alpha + ps;
    st.o0 = st.o0 * alpha; st.o1 = st.o1 * alpha;
    bf16x8_t pf[2];
#pragma unroll
    for (int k2 = 0; k2 < 2; ++k2) { uint4 w; w.x = pk2(s[8 * k2 + 0], s[8 * k2 + 1]); w.y = pk2(s[8 * k2 + 2], s[8 * k2 + 3]); w.z = pk2(s[8 * k2 + 4], s[8 * k2 + 5]); w.w = pk2(s[8 * k2 + 6], s[8 * k2 + 7]);
        pf[k2] = __builtin_bit_cast(bf16x8_t, w); }
    LAS const unsigned char* vp = buf + AV_OFF + q * AV_PITCH + (koff + 4 * h) * 2;
#pragma unroll
    for (int k2 = 0; k2 < 2; ++k2) {
        { const u32x2_t lo = *(LAS const u32x2_t*)(vp + k2 * 32), hi = *(LAS const u32x2_t*)(vp + k2 * 32 + 16); const u32x4_t w = {lo.x, lo.y, hi.x, hi.y};
          st.o0 = __builtin_amdgcn_mfma_f32_32x32x16_bf16(__builtin_bit_cast(bf16x8_t, w), pf[k2], st.o0, 0, 0, 0); }
        { const u32x2_t lo = *(LAS const u32x2_t*)(vp + 32 * AV_PITCH + k2 * 32), hi = *(LAS const u32x2_t*)(vp + 32 * AV_PITCH + k2 * 32 + 16); const u32x4_t w = {lo.x, lo.y, hi.x, hi.y};
          st.o1 = __builtin_amdgcn_mfma_f32_32x32x16_bf16(__builtin_bit_cast(bf16x8_t, w), pf[k2], st.o1, 0, 0, 0); }
    }
}
__device__ __forceinline__ void attn_init(AttnSt& st, bf16x8_t (&qf)[4], const bf16_t* qrow, int lane, bool has_sink, float sink) {
    const int h = lane >> 5;
#pragma unroll
    for (int ds = 0; ds < 4; ++ds) qf[ds] = *(const bf16x8_t*)(qrow + 16 * ds + 8 * h);
#pragma unroll
    for (int r = 0; r < 16; ++r) { st.o0[r] = 0.f; st.o1[r] = 0.f; }
    st.m2 = has_sink ? sink * LOG2E : NEGBIG; st.l = (has_sink && h == 0) ? 1.f : 0.f;
}
__device__ __forceinline__ void attn_finish(const AttnSt& st, bf16_t* orow, int lane) {
    const int h = lane >> 5;
    const float lt = st.l + __shfl_xor(st.l, 32), inv = 1.f / lt;
#pragma unroll
    for (int g = 0; g < 4; ++g) {
        uint2 w0, w1;
        w0.x = pk2(st.o0[4 * g] * inv, st.o0[4 * g + 1] * inv); w0.y = pk2(st.o0[4 * g + 2] * inv, st.o0[4 * g + 3] * inv);
        w1.x = pk2(st.o1[4 * g] * inv, st.o1[4 * g + 1] * inv); w1.y = pk2(st.o1[4 * g + 2] * inv, st.o1[4 * g + 3] * inv);
        *(uint2*)(orow + 8 * g + 4 * h) = w0; *(uint2*)(orow + 32 + 8 * g + 4 * h) = w1;
    }
}
struct SfPlain { __device__ __forceinline__ float operator()(float raw, int) const { return raw * ATT_SC; } };
struct SfWin { int rel;
    __device__ __forceinline__ float operator()(float raw, int key) const { const int dd = rel + key; return (dd >= -128 && dd <= 128) ? raw * ATT_SC : NEGBIG; } };
struct SfNat { LAS const float* rpb; int kc0, dr, wlo, qc; bool rowok;
    __device__ __forceinline__ float operator()(float raw, int key) const {
        const int kc = kc0 + key; const bool ok = rowok && kc >= wlo && kc < wlo + 16;
        const int dc = min(max(kc - qc + 15, 0), 30);
        return ok ? raw * ATT_SC + rpb[dr * 31 + dc] : NEGBIG; } };

template <class BaseOf, class Comp> __device__ __forceinline__ void attn_tiles(LAS unsigned char* lds, int NT, int pitch, int kcol, int vcol, int tid, const BaseOf& base_of, const Comp& comp) {
    StageRegs sr;
    attn_load_tile(sr, base_of(0), pitch, kcol, vcol, tid);
    attn_store_tile(sr, lds, tid);
    __syncthreads();
    for (int t = 0; t < NT; ++t) {
        if (t + 1 < NT) attn_load_tile(sr, base_of(t + 1), pitch, kcol, vcol, tid);
        comp(t, (LAS const unsigned char*)(lds + (t & 1) * ABUF));
        if (t + 1 < NT) attn_store_tile(sr, lds + ((t + 1) & 1) * ABUF, tid);
        __syncthreads();
    }
}

__device__ __forceinline__ void attnB_phase(const AV& a, LAS unsigned char* lds, int j, bool need_ctx) {
    const int tid = otid(a), lane = tid & 63, wave = tid >> 6;
    const bf16_t* QKVB = (const bf16_t*)(a.ws() + WS_QKVB); bf16_t* MIX = (bf16_t*)(a.ws() + WS_UMIX);
    const int nitems = 512 + (need_ctx ? 64 : 0);
    for (int it = obid(); it < nitems; it += gridDim.x) {
        const bool ctxq = it >= 512; const int i2 = ctxq ? it - 512 : it;
        const int b = ctxq ? (i2 >> 3) : (i2 >> 6), kvh = ctxq ? ((i2 >> 2) & 1) : ((i2 >> 5) & 1), qc = ctxq ? (i2 & 3) : (i2 & 31);
        const int hq = kvh * 4 + (wave >> 1), tq = qc * 64 + 32 * (wave & 1) + (lane & 31);
        const size_t m = ctxq ? (size_t)ML + b * CTXL + tq : (size_t)b * SEQ + tq;
        AttnSt st; bf16x8_t qf[4];
        attn_init(st, qf, QKVB + m * 768 + hq * 64, lane, true, a.in(I_SINK)[j * 8 + hq]);
        const int tb0 = max(qc - 2, 0), tb1 = min(qc + 2, 31);
        const int NT = ctxq ? 4 : 4 + (tb1 - tb0 + 1);
        const bf16_t* cbase = QKVB + ((size_t)ML + b * CTXL) * 768; const bf16_t* lbase = QKVB + (size_t)b * SEQ * 768;
        attn_tiles(lds, NT, 768, 512 + kvh * 64, 640 + kvh * 64, tid,
            [&](int t) { return t < 4 ? cbase + (size_t)t * 64 * 768 : lbase + (size_t)(tb0 + t - 4) * 64 * 768; },
            [&](int t, LAS const unsigned char* buf) {
                if (t < 4) { attn_subtile(st, qf, buf, 0, lane, SfPlain{}); attn_subtile(st, qf, buf, 32, lane, SfPlain{}); }
                else { const SfWin sf{(tb0 + t - 4) * 64 - tq}; attn_subtile(st, qf, buf, 0, lane, sf); attn_subtile(st, qf, buf, 32, lane, sf); }
            });
        attn_finish(st, MIX + m * 1024 + 512 + hq * 64, lane);
    }
}

__device__ __forceinline__ void attnCD_phase(const AV& a, LAS unsigned char* lds, int j, bool need_ctx) {
    const int tid = otid(a), lane = tid & 63, wave = tid >> 6;
    const bf16_t* P = (const bf16_t*)(a.ws() + WS_A); bf16_t* MIX = (bf16_t*)(a.ws() + WS_UMIX);
    LAS float* rpbs = (LAS float*)(lds + 2 * ABUF);
    const int nitems = 1024 + (need_ctx ? 128 : 0);
    for (int it = obid(); it < nitems; it += gridDim.x) {
        if (it < 512 || (it >= 1024 && it < 1088)) {
            const bool ctxq = it >= 1024; const int i2 = ctxq ? it - 1024 : it;
            const int b = ctxq ? (i2 >> 3) : (i2 >> 6), kvh = ctxq ? ((i2 >> 2) & 1) : ((i2 >> 5) & 1), qc = ctxq ? (i2 & 3) : (i2 & 31);
            const int hq = kvh * 4 + (wave >> 1), tq = qc * 64 + 32 * (wave & 1) + (lane & 31);
            const size_t m = ctxq ? (size_t)ML + b * CTXL + tq : (size_t)b * SEQ + tq;
            AttnSt st; bf16x8_t qf[4];
            attn_init(st, qf, P + m * NPO + 1536 + hq * 64, lane, false, 0.f);
            const int NT = ctxq ? 4 : 36;
            const bf16_t* cbase = P + ((size_t)ML + b * CTXL) * NPO; const bf16_t* lbase = P + (size_t)b * SEQ * NPO;
            attn_tiles(lds, NT, NPO, 2048 + kvh * 64, 2176 + kvh * 64, tid,
                [&](int t) { return t < 4 ? cbase + (size_t)t * 64 * NPO : lbase + (size_t)(t - 4) * 64 * NPO; },
                [&](int t, LAS const unsigned char* buf) { attn_subtile(st, qf, buf, 0, lane, SfPlain{}); attn_subtile(st, qf, buf, 32, lane, SfPlain{}); });
            attn_finish(st, MIX + m * 1024 + 512 + hq * 64, lane);
        } else if (it < 1024) {
            const int i2 = it - 512; const int b = i2 >> 6, h = (i2 >> 3) & 7, r0 = (i2 & 7) * 4;
            const float* rpb = a.in(I_RPB) + ((size_t)j * 8 + h) * 465;
            for (int i = tid; i < 465; i += NTHR) rpbs[i] = rpb[i] * LOG2E;
            const int q = lane & 31, rp = wave >> 2, mb = wave & 3;
            const int qr = r0 + 2 * rp + (q >> 4), qcol = 16 * mb + (q & 15), tq = qr * 64 + qcol;
            const size_t m = (size_t)b * SEQ + tq;
            AttnSt st; bf16x8_t qf[4];
            attn_init(st, qf, P + m * NPO + h * 64, lane, false, 0.f);
            const int krlo = min(max(r0 - 4, 0), 24), krhi = min(max(r0 + 3 - 4, 0), 24) + 7;
            const int NT = 4 + (krhi - krlo + 1);
            const int kc0 = min(max(16 * mb - 8, 0), 32);
            const int wrow = min(max(qr - 4, 0), 24), wlo = min(max(qcol - 8, 0), 48);
            const int ra = r0 + 2 * rp, ulo = min(max(ra - 4, 0), 24), uhi = min(max(ra + 1 - 4, 0), 24) + 7;
            const bf16_t* cbase = P + ((size_t)ML + b * CTXL) * NPO; const bf16_t* lbase = P + (size_t)b * SEQ * NPO;
            attn_tiles(lds, NT, NPO, 512 + h * 64, 1024 + h * 64, tid,
                [&](int t) { return t < 4 ? cbase + (size_t)t * 64 * NPO : lbase + (size_t)(krlo + t - 4) * 64 * NPO; },
                [&](int t, LAS const unsigned char* buf) {
                    if (t < 4) { attn_subtile(st, qf, buf, 0, lane, SfPlain{}); attn_subtile(st, qf, buf, 32, lane, SfPlain{}); }
                    else { const int kr = krlo + t - 4;
                        if (kr >= ulo && kr <= uhi) { const SfNat sf{rpbs, 0, kr - qr + 7, wlo, qcol, kr >= wrow && kr < wrow + 8}; attn_subtile(st, qf, buf, kc0, lane, sf); } }
                });
            attn_finish(st, MIX + m * 1024 + h * 64, lane);
        } else {
            const int i2 = it - 1088; const int b = i2 >> 3, h = i2 & 7;
            const int tq = 32 * wave + (lane & 31);
            const size_t m = (size_t)ML + b * CTXL + tq;
            AttnSt st; bf16x8_t qf[4];
            attn_init(st, qf, P + m * NPO + h * 64, lane, false, 0.f);
            const bf16_t* cbase = P + ((size_t)ML + b * CTXL) * NPO;
            attn_tiles(lds, 4, NPO, 512 + h * 64, 1024 + h * 64, tid,
                [&](int t) { return cbase + (size_t)t * 64 * NPO; },
                [&](int t, LAS const unsigned char* buf) { attn_subtile(st, qf, buf, 0, lane, SfPlain{}); attn_subtile(st, qf, buf, 32, lane, SfPlain{}); });
            attn_finish(st, MIX + m * 1024 + h * 64, lane);
        }
    }
}

constexpr int SC_TS = 32, SC_OPS = SC_TS * 5 * 64 * 4, SC_V = SC_TS * 32 * 4, SC_BUF = SC_OPS + SC_V, SC_YOFF = 2 * SC_BUF;
__device__ __forceinline__ float dpp_sum16(float v) {
    v += __builtin_bit_cast(float, __builtin_amdgcn_update_dpp(0, __builtin_bit_cast(int, v), 0xB1, 0xf, 0xf, true));
    v += __builtin_bit_cast(float, __builtin_amdgcn_update_dpp(0, __builtin_bit_cast(int, v), 0x4E, 0xf, 0xf, true));
    v += __builtin_bit_cast(float, __builtin_amdgcn_update_dpp(0, __builtin_bit_cast(int, v), 0x141, 0xf, 0xf, true));
    v += __builtin_bit_cast(float, __builtin_amdgcn_update_dpp(0, __builtin_bit_cast(int, v), 0x140, 0xf, 0xf, true));
    return v;
}
struct ScanRegs { uint2 r, k, kk, e, ai; unsigned v; };
__device__ __forceinline__ void scan_phase(const AV& a, LAS unsigned char* lds, int j) {
    const int tid = otid(a);
    const int st = tid >> 4, part = tid & 15;
    const bf16_t* RB = (const bf16_t*)(a.ws() + WS_B); const bf16_t* KB = RB + TOK512; const bf16_t* VB = RB + 2 * TOK512; const bf16_t* KKB = RB + 3 * TOK512;
    for (int it = obid(); it < 256; it += gridDim.x) {
        const int half = it & 1, cb = it >> 1, dir = cb & 1, h = (cb >> 1) & 7, b = cb >> 4;
        const bf16_t* LR = (const bf16_t*)(a.ws() + WS_A) + dir * 512 + h * 64 + 4 * part;
        float* Y = (float*)(a.ws() + WS_B + (dir ? B_Y1 : B_Y0));
        const f32x4 w0 = *(const f32x4*)(a.in(I_W0) + j * 1024 + dir * 512 + h * 64 + 4 * part), a0 = *(const f32x4*)(a.in(I_A0) + j * 1024 + dir * 512 + h * 64 + 4 * part),
                    ka = *(const f32x4*)(a.in(I_KA) + j * 512 + h * 64 + 4 * part);
        auto tok = [&](int ck, int s_) -> size_t {
            if (ck < 8) { const int t = 32 * ck + s_; return (size_t)ML + b * CTXL + (dir ? (CTXL - 1 - t) : t); }
            const int t = 32 * (ck - 8) + s_; return (size_t)b * SEQ + (dir ? (SEQ - 1 - t) : t); };
        auto gload = [&](ScanRegs& g, int ck) {
            const size_t m = tok(ck, st); const size_t o = m * 512 + h * 64 + 4 * part;
            g.r = *(const uint2*)(RB + o); g.k = *(const uint2*)(KB + o); g.kk = *(const uint2*)(KKB + o);
            g.e = *(const uint2*)(LR + m * NLR); g.ai = *(const uint2*)(LR + m * NLR + 1024);
            g.v = *(const unsigned*)(VB + m * 512 + h * 64 + 32 * half + 2 * part); };
        auto gstore = [&](const ScanRegs& g, LAS unsigned char* buf) {
            const f32x4 r = {bflo(g.r.x), bfhi(g.r.x), bflo(g.r.y), bfhi(g.r.y)}, k = {bflo(g.k.x), bfhi(g.k.x), bflo(g.k.y), bfhi(g.k.y)},
                        kk = {bflo(g.kk.x), bfhi(g.kk.x), bflo(g.kk.y), bfhi(g.kk.y)};
            f32x4 e = {bflo(g.e.x), bfhi(g.e.x), bflo(g.e.y), bfhi(g.e.y)}, ai = {bflo(g.ai.x), bfhi(g.ai.x), bflo(g.ai.y), bfhi(g.ai.y)};
            f32x4 w, bb, kd;
#pragma unroll
            for (int i = 0; i < 4; ++i) { const float ee = 0.60653065971263342f * sigmoidf_(e[i] + w0[i]); const float aa = sigmoidf_(ai[i] + a0[i]);
                w[i] = __expf(-ee); bb[i] = kk[i] * aa; kd[i] = k[i] * (1.f + (aa - 1.f) * ka[i]); }
            LAS float* op = (LAS float*)(buf + st * 1280) + 4 * part;
            *(LAS f32x4*)(op) = kk; *(LAS f32x4*)(op + 64) = w; *(LAS f32x4*)(op + 128) = bb; *(LAS f32x4*)(op + 192) = kd; *(LAS f32x4*)(op + 256) = r;
            LAS float* vp = (LAS float*)(buf + SC_OPS) + st * 32 + 2 * part; vp[0] = bflo(g.v); vp[1] = bfhi(g.v); };
        ScanRegs g; gload(g, 0); gstore(g, lds);
        __syncthreads();
        f32x4 S = {0.f, 0.f, 0.f, 0.f};
        LAS float* ybuf = (LAS float*)(lds + SC_YOFF);
        for (int ck = 0; ck < 72; ++ck) {
            if (ck + 1 < 72) gload(g, ck + 1);
            LAS const unsigned char* buf = lds + (ck & 1) * SC_BUF;
#pragma unroll 4
            for (int s_ = 0; s_ < SC_TS; ++s_) {
                LAS const float* op = (LAS const float*)(buf + s_ * 1280) + 4 * part;
                const f32x4 kk = *(LAS const f32x4*)(op), w = *(LAS const f32x4*)(op + 64), bb = *(LAS const f32x4*)(op + 128), kd = *(LAS const f32x4*)(op + 192), r = *(LAS const f32x4*)(op + 256);
                const float vv = ((LAS const float*)(buf + SC_OPS))[s_ * 32 + st];
                float d = (S[0] * kk[0] + S[1] * kk[1]) + (S[2] * kk[2] + S[3] * kk[3]);
                d = dpp_sum16(d);
                const float sa = -d;
                S = S * w + bb * sa + kd * vv;
                float y = (S[0] * r[0] + S[1] * r[1]) + (S[2] * r[2] + S[3] * r[3]);
                y = dpp_sum16(y);
                if (part == 0) ybuf[s_ * 32 + st] = y;
            }
            __syncthreads();
            if (ck + 1 < 72) gstore(g, lds + ((ck + 1) & 1) * SC_BUF);
            { const size_t m = tok(ck, st); const float y0 = ybuf[st * 32 + 2 * part], y1 = ybuf[st * 32 + 2 * part + 1];
              *(float2*)(Y + m * 512 + h * 64 + 32 * half + 2 * part) = make_float2(y0, y1); }
            __syncthreads();
        }
    }
}

#define XB_TMO      128
#define XB_XCNT(j)  (256  + 64 * (j))
#define XB_XSUB(j)  (1280 + 64 * (j))
#define XB_XGEN(j)  (2304 + 64 * (j))
#define XB_TOP      3328
#define XB_TOPGEN   3392
#define XCD_BAR_WORDS 3456
#define XB_SPIN_CAP (1u << 18)

__device__ __forceinline__ unsigned xb_ld(unsigned* p)              { return __hip_atomic_load(p, __ATOMIC_RELAXED, __HIP_MEMORY_SCOPE_AGENT); }
__device__ __forceinline__ unsigned xb_add(unsigned* p, unsigned v) { return __hip_atomic_fetch_add(p, v, __ATOMIC_RELAXED, __HIP_MEMORY_SCOPE_AGENT); }
__device__ __forceinline__ unsigned xb_xcc_id() { return (unsigned)__builtin_amdgcn_s_getreg((3 << 11) | 20) & 0xFu; }
#define XB_SPIN(cond, bar) do { unsigned _sp = 0; while (cond) { __builtin_amdgcn_s_sleep(1); \
    if ((++_sp & 255u) == 0u) { if (xb_ld(&(bar)[XB_TMO])) break; if (_sp > XB_SPIN_CAP) { atomicAdd(&(bar)[XB_TMO], 1u); break; } } } } while (0)

struct XcdBarrier {
    unsigned* bar; unsigned x;
    volatile LAS unsigned* st;
};

__device__ __forceinline__ XcdBarrier xcd_barrier_post(unsigned* bar, volatile LAS unsigned* st, int tid) {
    XcdBarrier b; b.bar = bar; b.x = xb_xcc_id(); b.st = st;
    if (tid == 0) (void)xb_add(&bar[XB_XCNT(b.x)], 1u);
    return b;
}
__device__ __forceinline__ void xcd_barrier_complete(unsigned* bar, unsigned x, unsigned& nloc, unsigned& nx) {
    const unsigned G = gridDim.x * gridDim.y * gridDim.z;
    unsigned sum, cnt, mine, sp = 0u;
    for (;;) {
        sum = 0u; cnt = 0u; mine = 0u;
#pragma unroll
        for (unsigned j = 0; j < 16; ++j) { const unsigned c = xb_ld(&bar[XB_XCNT(j)]); sum += c; cnt += (c > 0u) ? 1u : 0u; mine = (j == x) ? c : mine; }
        if (sum == G) break;
        __builtin_amdgcn_s_sleep(1);
        if ((++sp & 255u) == 0u) { if (xb_ld(&bar[XB_TMO])) break; if (sp > XB_SPIN_CAP) { atomicAdd(&bar[XB_TMO], 1u); break; } }
    }
    nloc = mine > 0u ? mine : 1u; nx = cnt > 0u ? cnt : 1u;
}

__device__ __forceinline__ void xcd_barrier(const XcdBarrier& b, int tid) {
    asm volatile("s_waitcnt vmcnt(0)" ::: "memory");
    __syncthreads();
    if (tid == 0) {
        unsigned* bar = b.bar;
        __builtin_amdgcn_s_waitcnt(0);
        unsigned nloc = b.st[0], nx = b.st[1];
        if (nloc == 0u) { xcd_barrier_complete(bar, b.x, nloc, nx); b.st[0] = nloc; b.st[1] = nx; }
        const unsigned old = xb_add(&bar[XB_XSUB(b.x)], 1u);
        const unsigned gen = old / nloc;
        if (old + 1u == (gen + 1u) * nloc) {
            __builtin_amdgcn_fence(__ATOMIC_RELEASE, "agent");
            asm volatile("s_waitcnt vmcnt(0)" ::: "memory");
            const unsigned og = xb_add(&bar[XB_TOP], 1u);
            const unsigned tg = og / nx;
            if (og + 1u == (tg + 1u) * nx) xb_add(&bar[XB_TOPGEN], 1u);
            else XB_SPIN(xb_ld(&bar[XB_TOPGEN]) == tg, bar);
            __builtin_amdgcn_fence(__ATOMIC_ACQUIRE, "agent");
            xb_add(&bar[XB_XGEN(b.x)], 1u);
            asm volatile("s_waitcnt vmcnt(0)" ::: "memory");
        } else {
            XB_SPIN(xb_ld(&bar[XB_XGEN(b.x)]) == gen, bar);
            __builtin_amdgcn_fence(__ATOMIC_ACQUIRE, "agent");
            asm volatile("s_waitcnt vmcnt(0)" ::: "memory");
        }
    }
    __syncthreads();
}

enum { OP_SETUP = 0, OP_NORM0, OP_GEMM_IN, OP_PREP1, OP_GEMM_LORA, OP_SCAN, OP_RWKVOUT, OP_QKNORM, OP_ATTNCD, OP_GEMM_OUT, OP_NORM_H, OP_GEMM_FF1, OP_GEMM_FF2, OP_NORM_K };
__device__ __forceinline__ void decode_phase(int ph, int& layer, int& op) {
    if (ph < 2) { layer = 0; op = ph; return; }
    int r = ph - 2; layer = 0;
    if (r >= 10) { r -= 10; layer = 1; if (r >= 8) { r -= 8; layer = 2; if (r >= 10) { r -= 10; layer = 3; } } }
    if ((layer & 1) == 0) { const int t[10] = {OP_GEMM_IN, OP_PREP1, OP_GEMM_LORA, OP_SCAN, OP_RWKVOUT, OP_GEMM_OUT, OP_NORM_H, OP_GEMM_FF1, OP_GEMM_FF2, OP_NORM_K}; op = OP_GEMM_IN;
#pragma unroll
        for (int q = 0; q < 10; ++q) if (r == q) op = t[q]; }
    else { const int t[8] = {OP_GEMM_IN, OP_QKNORM, OP_ATTNCD, OP_GEMM_OUT, OP_NORM_H, OP_GEMM_FF1, OP_GEMM_FF2, OP_NORM_K}; op = OP_GEMM_IN;
#pragma unroll
        for (int q = 0; q < 8; ++q) if (r == q) op = t[q]; }
}
#ifndef PROBE_MASK
#define PROBE_MASK 0
#define PROBE_REP 1
#define PROBE_XSYNC 0
#endif
__global__ void __launch_bounds__(NTHR, 2) trunk_fwd(Args a_) {
    extern __shared__ __attribute__((aligned(16))) unsigned char lds_raw[];
    LAS unsigned char* lds = (LAS unsigned char*)lds_raw;
    cg::grid_group grid = cg::this_grid();
    const int lo = a_.ph_lo, hi = a_.ph_hi;
    const int wv_ = __builtin_amdgcn_readfirstlane((int)threadIdx.x >> 6);
    const int G = gridDim.x;
    volatile LAS unsigned* bst = (volatile LAS unsigned*)(lds + LDS_BYTES - 64);
    if ((int)threadIdx.x < 16) bst[threadIdx.x] = 0u;
    __syncthreads();
    XcdBarrier xbar = xcd_barrier_post((unsigned*)a_.ws, bst, (int)threadIdx.x);
    for (int ph = lo; ph < hi; ++ph) {
        int z_; asm volatile("s_mov_b32 %0, 0" : "=s"(z_)); const AV a{a_, z_, wv_};
        int layer, op; decode_phase(ph, layer, op);
        const bool even = (layer & 1) == 0; const int j = layer >> 1; const bool need_ctx = layer < 3;
        const int Mrows = need_ctx ? MT : ML;
        float* MOD = (float*)(a.ws() + WS_MOD); const float* modl = MOD + (size_t)layer * 9 * 6144;
        bf16_t* UMIX = (bf16_t*)(a.ws() + WS_UMIX);
        const int reps = ((PROBE_MASK >> op) & 1) ? PROBE_REP : 1;
        for (int rep = 0; rep < reps; ++rep) {
        if (op == OP_SETUP) { mod_phase(a, lds); rope_phase(a); wconv_phase(a, lds, 0); }
        else if (op == OP_NORM0 || op == OP_NORM_H || op == OP_NORM_K) {
            NormJob jb;
            if (op == OP_NORM0) { jb.rows = MT; jb.o_src = nullptr; jb.gate = nullptr; jb.gpost = nullptr; jb.h_in_input = true; jb.write_h = false;
                jb.shift = MOD + 0 * 1024; jb.scale = MOD + 1 * 1024; jb.gpre = a.in(I_GPREMIX); }
            else if (op == OP_NORM_H) { jb.rows = Mrows; jb.o_src = (const float*)(a.ws() + WS_A); jb.gate = modl + 2 * 1024; jb.gpost = a.in(I_GPOSTMIX) + layer * D;
                jb.h_in_input = (layer == 0); jb.write_h = true; jb.shift = modl + 3 * 1024; jb.scale = modl + 4 * 1024; jb.gpre = a.in(I_GPREFF) + layer * D; }
            else { jb.rows = Mrows; jb.o_src = (const float*)(a.ws() + WS_O2); jb.gate = modl + 5 * 1024; jb.gpost = a.in(I_GPOSTFF) + layer * D; jb.h_in_input = false; jb.write_h = true;
                if (layer < 3) { const float* modn = modl + 9 * 6144; jb.shift = modn + 0 * 1024; jb.scale = modn + 1 * 1024; jb.gpre = a.in(I_GPREMIX) + (layer + 1) * D; }
                else { jb.shift = nullptr; jb.scale = nullptr; jb.gpre = nullptr; } }
            norm_phase(a, jb);
            if (op == OP_NORM_K && layer < 3) wconv_phase(a, lds, layer + 1);
        }
        else if (op == OP_GEMM_IN || op == OP_GEMM_LORA || op == OP_GEMM_FF1) {
            pg8::Gemm g; bf16_t* O; int ldc;
            if (op == OP_GEMM_IN) { const int NP = even ? NPE : NPO; g = pg8::Gemm{UMIX, (const bf16_t*)(a.ws() + WS_W + W_IN), MT, NP, D, D}; O = (bf16_t*)(a.ws() + WS_A); ldc = NP; }
            else if (op == OP_GEMM_LORA) { g = pg8::Gemm{UMIX, (const bf16_t*)(a.ws() + WS_W + W_L), MT, NLR, 384, 1024}; O = (bf16_t*)(a.ws() + WS_A); ldc = NLR; }
            else { g = pg8::Gemm{UMIX, (const bf16_t*)(a.ws() + WS_W + W_1), Mrows, FF, D, D}; O = (bf16_t*)(a.ws() + WS_A); ldc = FF; }
            pg8::StaticOrder S; S.init(g.M, g.N, G, obid());
            pg8::EpiBf16 E{O, ldc, op == OP_GEMM_FF1};
            pg8::gemm_phase<pg8::EpiBf16, pg8::StaticOrder, true, true>(lds, g, S, E, otid(a));
        }
        else if (op == OP_GEMM_OUT || op == OP_GEMM_FF2) {
            pg8::Gemm g; float* O;
            if (op == OP_GEMM_OUT) { g = pg8::Gemm{UMIX, (const bf16_t*)(a.ws() + WS_W + W_OUT), Mrows, D, D, D}; O = (float*)(a.ws() + WS_A); }
            else { g = pg8::Gemm{(const bf16_t*)(a.ws() + WS_A), (const bf16_t*)(a.ws() + WS_W + W_2), Mrows, D, FF, FF}; O = (float*)(a.ws() + WS_O2); }
            pg8::StaticOrder S; S.init(g.M, g.N, G, obid());
            pg8::EpiF32 E{O, D};
            pg8::gemm_phase<pg8::EpiF32, pg8::StaticOrder, true, true>(lds, g, S, E, otid(a));
        }
        else if (op == OP_PREP1) prep1_phase(a, j);
        else if (op == OP_SCAN) { scan_phase(a, lds, j); attnB_phase(a, lds, j, need_ctx); }
        else if (op == OP_RWKVOUT) rwkv_out_phase(a, j);
        else if (op == OP_QKNORM) qknorm_phase(a, j);
        else if (op == OP_ATTNCD) attnCD_phase(a, lds, j, need_ctx);
        }
        if (ph + 1 < hi) {
            if (ph == lo) grid.sync();
            else xcd_barrier(xbar, otid(a));
            for (int e_ = 0; e_ < PROBE_XSYNC; ++e_) xcd_barrier(xbar, otid(a));
        }
    }
}

#ifndef N_LAUNCH_MODE
#define N_LAUNCH_MODE 1
#endif
extern "C" void kernel_launch(void* const* d_in, const int* in_sizes, int n_in, void* d_out, int out_size, void* d_ws, size_t ws_size, hipStream_t stream) {
    static int grid = 0;
    if (grid == 0) {
        if (n_in != N_IN || out_size != ML * D || ws_size < WS_END) { fprintf(stderr, "kernel_launch: unexpected shapes (n_in %d out %d ws %zu need %zu)\n", n_in, out_size, ws_size, (size_t)WS_END); grid = -1; return; }
        int dev = 0, cus = 0, per_cu = 0;
        (void)hipGetDevice(&dev); (void)hipDeviceGetAttribute(&cus, hipDeviceAttributeMultiprocessorCount, dev);
        (void)hipFuncSetAttribute((const void*)trunk_fwd, hipFuncAttributeMaxDynamicSharedMemorySize, LDS_BYTES);
        (void)hipOccupancyMaxActiveBlocksPerMultiprocessor(&per_cu, (const void*)trunk_fwd, NTHR, LDS_BYTES);
        if (per_cu < 1) per_cu = 1;
        grid = cus;
        fprintf(stderr, "kernel_launch: cus %d per_cu %d grid %d ws %zu\n", cus, per_cu, grid, ws_size);
    }
    if (grid < 0) return;
    (void)hipMemsetAsync(d_ws, 0, 16384, stream);
    Args a{};
    for (int i = 0; i < N_IN; ++i) a.in[i] = (const float*)d_in[i];
    a.out = (float*)d_out; a.ws = (unsigned char*)d_ws;
#if N_LAUNCH_MODE == 1
    a.ph_lo = 0; a.ph_hi = NPH;
    void* args[] = {&a};
    hipError_t e = hipLaunchCooperativeKernel((const void*)trunk_fwd, dim3(grid), dim3(NTHR), args, LDS_BYTES, stream);
    if (e != hipSuccess) fprintf(stderr, "cooperative launch failed: %s\n", hipGetErrorString(e));
#else
    for (int p = 0; p < NPH; ++p) { a.ph_lo = p; a.ph_hi = p + 1; hipLaunchKernelGGL(trunk_fwd, dim3(grid), dim3(NTHR), LDS_BYTES, stream, a); }
#endif
}
```
